# Optimizing an MI355X kernel written in HIP

```python
import math
import jax, jax.numpy as jnp
from jax import lax
import numpy as np

D_MODEL = 1024
BATCH = 8
SEQ = 4096
DEPTH = 1

HEAD_DIM = 64
N_HEADS = D_MODEL // HEAD_DIM
H_FOX = N_HEADS // 2
H_MOBA = N_HEADS - H_FOX
W_FOX = H_FOX * HEAD_DIM
W_MOBA = H_MOBA * HEAD_DIM
IN_COLS = 3 * W_FOX + H_FOX + 3 * W_MOBA
Q_BLOCK = 128
MOBA_BLOCK = 256
MOBA_TOPK = 3
N_BUCKETS = 32
MAX_DISTANCE = 128
D_FF = -(-8 * D_MODEL // (3 * 256)) * 256
EPS = 1e-6
FORGET_BIAS_INIT = 3.0

kernel_name = "hybrid_fox_moba_adaln_block"


def rms_norm(x, g):
    xf = x.astype(jnp.float32)
    y = xf * lax.rsqrt(jnp.mean(xf * xf, axis=-1, keepdims=True) + EPS)
    return (y * g.astype(jnp.float32)).astype(x.dtype)


def t5_bucket(dist):
    n = jnp.maximum(dist, 0)
    max_exact = N_BUCKETS // 2
    nf = jnp.maximum(n, 1).astype(jnp.float32)
    large = max_exact + (jnp.log(nf / max_exact) / math.log(MAX_DISTANCE / max_exact)
                         * (N_BUCKETS - max_exact)).astype(jnp.int32)
    large = jnp.minimum(large, N_BUCKETS - 1)
    return jnp.where(n < max_exact, n, large)


def fox_attention(q, k, v, log_f_cum):
    B, H, S, Dh = q.shape
    n_blocks = S // Q_BLOCK
    scale = HEAD_DIM ** -0.5
    k_pos = jnp.arange(S)

    def block(i):
        start = i * Q_BLOCK
        q_blk = lax.dynamic_slice_in_dim(q, start, Q_BLOCK, axis=2)
        f_blk = lax.dynamic_slice_in_dim(log_f_cum, start, Q_BLOCK, axis=2)
        s = jnp.einsum('bhqd,bhkd->bhqk', q_blk, k,
                       preferred_element_type=jnp.float32) * scale
        s = s + f_blk[..., :, None] - log_f_cum[..., None, :]
        q_pos = start + jnp.arange(Q_BLOCK)
        causal = k_pos[None, :] <= q_pos[:, None]
        s = jnp.where(causal, s, -jnp.inf)
        p = jax.nn.softmax(s, axis=-1)
        return jnp.einsum('bhqk,bhkd->bhqd', p.astype(v.dtype), v)

    out = lax.map(block, jnp.arange(n_blocks))
    return jnp.transpose(out, (1, 0, 3, 2, 4)).reshape(B, S, H * Dh)


def moba_attention(q, k, v, rel_bias):
    B, H, S, Dh = q.shape
    nb = -(-S // MOBA_BLOCK)
    pad = nb * MOBA_BLOCK - S
    kb = jnp.pad(k, ((0, 0), (0, 0), (0, pad), (0, 0))).reshape(B, H, nb, MOBA_BLOCK, Dh)
    vb = jnp.pad(v, ((0, 0), (0, 0), (0, pad), (0, 0))).reshape(B, H, nb, MOBA_BLOCK, Dh)
    counts = jnp.clip(S - jnp.arange(nb) * MOBA_BLOCK, 1, MOBA_BLOCK).astype(jnp.float32)
    k_mean = jnp.sum(kb.astype(jnp.float32), axis=3) / counts[None, None, :, None]
    n_q = S // Q_BLOCK
    k_sel = min(MOBA_TOPK, nb)
    scale = HEAD_DIM ** -0.5
    offs = jnp.arange(MOBA_BLOCK)
    blk_ids = jnp.arange(nb)
    h_ix3 = jnp.arange(H)[:, None, None]
    h_ix4 = jnp.arange(H)[:, None, None, None]
    bias_hb = rel_bias.T.astype(jnp.float32)

    def chunk(n):
        b = n // n_q
        i = n % n_q
        start = i * Q_BLOCK
        q_b = lax.dynamic_index_in_dim(q, b, axis=0, keepdims=False)
        kb_b = lax.dynamic_index_in_dim(kb, b, axis=0, keepdims=False)
        vb_b = lax.dynamic_index_in_dim(vb, b, axis=0, keepdims=False)
        km_b = lax.dynamic_index_in_dim(k_mean, b, axis=0, keepdims=False)
        q_c = lax.dynamic_slice_in_dim(q_b, start, Q_BLOCK, axis=1)
        q_pos = start + jnp.arange(Q_BLOCK)
        own = start // MOBA_BLOCK
        g = jnp.einsum('hqd,hnd->hqn', q_c.astype(jnp.float32), km_b)
        g = jnp.where(blk_ids[None, None, :] < own, g, -jnp.inf)
        _, idx = lax.top_k(g, k_sel)
        valid = idx < own
        k_g = kb_b[h_ix3, idx]
        v_g = vb_b[h_ix3, idx]
        s_sel = jnp.einsum('hqd,hqnkd->hqnk', q_c, k_g,
                           preferred_element_type=jnp.float32) * scale
        pos_sel = idx[..., None] * MOBA_BLOCK + offs
        s_sel = s_sel + bias_hb[h_ix4, t5_bucket(q_pos[None, :, None, None] - pos_sel)]
        s_sel = jnp.where(valid[..., None], s_sel, -jnp.inf)
        k_own = lax.dynamic_index_in_dim(kb_b, own, axis=1, keepdims=False)
        v_own = lax.dynamic_index_in_dim(vb_b, own, axis=1, keepdims=False)
        s_own = jnp.einsum('hqd,hkd->hqk', q_c, k_own,
                           preferred_element_type=jnp.float32) * scale
        pos_own = own * MOBA_BLOCK + offs
        bkt_own = t5_bucket(q_pos[:, None] - pos_own[None, :])
        s_own = s_own + jnp.transpose(rel_bias.astype(jnp.float32)[bkt_own], (2, 0, 1))
        s_own = jnp.where(pos_own[None, None, :] <= q_pos[None, :, None], s_own, -jnp.inf)
        s_all = jnp.concatenate([s_sel.reshape(H, Q_BLOCK, k_sel * MOBA_BLOCK), s_own], axis=-1)
        p = jax.nn.softmax(s_all, axis=-1).astype(v.dtype)
        p_sel = p[..., :k_sel * MOBA_BLOCK].reshape(H, Q_BLOCK, k_sel, MOBA_BLOCK)
        p_own = p[..., k_sel * MOBA_BLOCK:]
        return (jnp.einsum('hqnk,hqnkd->hqd', p_sel, v_g)
                + jnp.einsum('hqk,hkd->hqd', p_own, v_own))

    out = lax.map(chunk, jnp.arange(B * n_q))
    out = out.reshape(B, n_q, H, Q_BLOCK, Dh)
    return jnp.transpose(out, (0, 1, 3, 2, 4)).reshape(B, S, H * Dh)


def setup_inputs(seed: int = 0) -> dict:
    key = jax.random.key(seed)
    ks = jax.random.split(key, 20)
    f32 = jnp.float32
    nrm = lambda k, shape: jax.random.normal(k, shape, dtype=f32)
    return {
        "x": nrm(ks[0], (BATCH, SEQ, D_MODEL)),
        "c": nrm(ks[1], (BATCH, D_MODEL)),
        "w_ada": nrm(ks[2], (DEPTH, D_MODEL, 6 * D_MODEL)) * (0.5 * D_MODEL ** -0.5),
        "b_ada": nrm(ks[3], (DEPTH, 6 * D_MODEL)) * 0.02,
        "norm1": 1.0 + 0.02 * nrm(ks[4], (DEPTH, D_MODEL)),
        "norm2": 1.0 + 0.02 * nrm(ks[5], (DEPTH, D_MODEL)),
        "w_in": nrm(ks[6], (DEPTH, D_MODEL, IN_COLS)) * D_MODEL ** -0.5,
        "b_forget": FORGET_BIAS_INIT + 0.5 * nrm(ks[7], (DEPTH, H_FOX)),
        "q_norm_fox": 1.0 + 0.02 * nrm(ks[8], (DEPTH, HEAD_DIM)),
        "k_norm_fox": 1.0 + 0.02 * nrm(ks[9], (DEPTH, HEAD_DIM)),
        "q_norm_moba": 1.0 + 0.02 * nrm(ks[10], (DEPTH, HEAD_DIM)),
        "k_norm_moba": 1.0 + 0.02 * nrm(ks[11], (DEPTH, HEAD_DIM)),
        "rel_bias": 0.2 * nrm(ks[12], (N_BUCKETS, H_MOBA)),
        "w_o": nrm(ks[13], (DEPTH, D_MODEL, D_MODEL)) * D_MODEL ** -0.5,
        "w_gate": nrm(ks[14], (DEPTH, D_MODEL, D_FF)) * D_MODEL ** -0.5,
        "w_up": nrm(ks[15], (DEPTH, D_MODEL, D_FF)) * D_MODEL ** -0.5,
        "w_down": nrm(ks[16], (DEPTH, D_FF, D_MODEL)) * D_FF ** -0.5,
    }


def reference(x, c, w_ada, b_ada, norm1, norm2, w_in, b_forget, q_norm_fox, k_norm_fox,
              q_norm_moba, k_norm_moba, rel_bias, w_o, w_gate, w_up, w_down):
    B, S, D = x.shape

    def heads(t, h):
        return jnp.transpose(t.reshape(B, S, h, HEAD_DIM), (0, 2, 1, 3))

    for l in range(DEPTH):
        mod = (jax.nn.silu(c) @ w_ada[l] + b_ada[l]).reshape(B, 6, D)[:, :, None, :]
        shift1, scale1, gate1, shift2, scale2, gate2 = [mod[:, j] for j in range(6)]

        h = rms_norm(x, norm1[l]) * (1 + scale1) + shift1
        proj = h @ w_in[l]
        o0 = 0
        fq = proj[..., o0:o0 + W_FOX]; o0 += W_FOX
        fk = proj[..., o0:o0 + W_FOX]; o0 += W_FOX
        fv = proj[..., o0:o0 + W_FOX]; o0 += W_FOX
        ff = proj[..., o0:o0 + H_FOX]; o0 += H_FOX
        mq = proj[..., o0:o0 + W_MOBA]; o0 += W_MOBA
        mk = proj[..., o0:o0 + W_MOBA]; o0 += W_MOBA
        mv = proj[..., o0:o0 + W_MOBA]

        fq = rms_norm(heads(fq, H_FOX), q_norm_fox[l])
        fk = rms_norm(heads(fk, H_FOX), k_norm_fox[l])
        fv = heads(fv, H_FOX)
        log_f = jax.nn.log_sigmoid(ff.astype(jnp.float32) + b_forget[l].astype(jnp.float32))
        log_f_cum = jnp.transpose(jnp.cumsum(log_f, axis=1), (0, 2, 1))
        fox_out = fox_attention(fq, fk, fv, log_f_cum)

        mq = rms_norm(heads(mq, H_MOBA), q_norm_moba[l])
        mk = rms_norm(heads(mk, H_MOBA), k_norm_moba[l])
        mv = heads(mv, H_MOBA)
        moba_out = moba_attention(mq, mk, mv, rel_bias)

        mix = jnp.concatenate([fox_out, moba_out], axis=-1).astype(x.dtype) @ w_o[l]
        x = x + gate1 * mix

        h2 = rms_norm(x, norm2[l]) * (1 + scale2) + shift2
        ffn = (jax.nn.silu(h2 @ w_gate[l]) * (h2 @ w_up[l])) @ w_down[l]
        x = x + gate2 * ffn
    return x
```

```cpp
#include <hip/hip_runtime.h>
#include <stdint.h>

typedef unsigned short bf16_t;
typedef short bf16x8 __attribute__((ext_vector_type(8)));
typedef float f32x4 __attribute__((ext_vector_type(4)));
typedef unsigned u32x2 __attribute__((ext_vector_type(2)));
typedef unsigned u32x4 __attribute__((ext_vector_type(4)));

constexpr int NB = 8, SEQ = 4096, DM = 1024, MROWS = NB * SEQ, DH = 64, INC = 3080, DFF = 2816, NQKV = 3072;
constexpr float EPS = 1e-6f;
constexpr float LOG2E = 1.4426950408889634f;
constexpr float C2 = 0.125f * LOG2E;
constexpr size_t MiB = 1u << 20;
constexpr size_t WS_MOD = 0, WS_LOGF = 1 * MiB, WS_FL2 = 2 * MiB, WS_SEL = 3 * MiB, WS_KMP = 4 * MiB;
constexpr size_t WS_WIN = 8 * MiB, WS_WO = 14 * MiB, WS_WGU = 16 * MiB, WS_WDN = 28 * MiB;
constexpr size_t WS_XN = 64 * MiB, WS_QKV = 128 * MiB, WS_H = 128 * MiB, WS_ATT = 320 * MiB;

__device__ const unsigned char T5B[128] = {0, 1, 2, 3, 4, 5, 6, 7, 8, 9, 10, 11, 12, 13, 14, 15, 16, 16, 16, 17, 17, 18, 18, 18, 19, 19, 19, 20, 20, 20, 20, 21, 21, 21, 21, 22, 22, 22, 22, 22, 23, 23, 23, 23, 23, 23, 24, 24, 24, 24, 24, 24, 25, 25, 25, 25, 25, 25, 25, 26, 26, 26, 26, 26, 26, 26, 26, 27, 27, 27, 27, 27, 27, 27, 27, 27, 27, 28, 28, 28, 28, 28, 28, 28, 28, 28, 28, 29, 29, 29, 29, 29, 29, 29, 29, 29, 29, 29, 29, 30, 30, 30, 30, 30, 30, 30, 30, 30, 30, 30, 30, 30, 30, 31, 31, 31, 31, 31, 31, 31, 31, 31, 31, 31, 31, 31, 31, 31};

__device__ __forceinline__ unsigned f2bf(float f) { unsigned u = __float_as_uint(f); return (u + 0x7fffu + ((u >> 16) & 1u)) >> 16; }
__device__ __forceinline__ unsigned pk2(float lo, float hi) { return f2bf(lo) | (f2bf(hi) << 16); }
__device__ __forceinline__ float bf2f(unsigned h) { return __uint_as_float(h << 16); }
__device__ __forceinline__ float wave_sum(float v) {
#pragma unroll
    for (int o = 1; o < 64; o <<= 1) v += __shfl_xor(v, o);
    return v;
}

__global__ __launch_bounds__(256) void k_mod(const float* __restrict__ c, const float* __restrict__ w_ada, const float* __restrict__ b_ada, float* __restrict__ mod) {
    __shared__ float sc[8 * 1024];
    __shared__ float red[4][8][64];
    const int tid = threadIdx.x;
    for (int i = tid; i < 8192; i += 256) { const float v = c[i]; sc[i] = v / (1.f + expf(-v)); }
    __syncthreads();
    const int l = tid & 63, col = blockIdx.x * 64 + l, kg = tid >> 6;
    float a0 = 0, a1 = 0, a2 = 0, a3 = 0, a4 = 0, a5 = 0, a6 = 0, a7 = 0;
    for (int k = kg * 256; k < kg * 256 + 256; ++k) {
        const float w = w_ada[(size_t)k * 6144 + col];
        a0 += sc[k] * w; a1 += sc[1024 + k] * w; a2 += sc[2048 + k] * w; a3 += sc[3072 + k] * w;
        a4 += sc[4096 + k] * w; a5 += sc[5120 + k] * w; a6 += sc[6144 + k] * w; a7 += sc[7168 + k] * w;
    }
    red[kg][0][l] = a0; red[kg][1][l] = a1; red[kg][2][l] = a2; red[kg][3][l] = a3; red[kg][4][l] = a4; red[kg][5][l] = a5; red[kg][6][l] = a6; red[kg][7][l] = a7;
    __syncthreads();
    if (kg == 0) {
#pragma unroll
        for (int b = 0; b < 8; ++b) mod[b * 6144 + col] = ((red[0][b][l] + red[1][b][l]) + (red[2][b][l] + red[3][b][l])) + b_ada[col];
    }
}

template <int MAP> __global__ __launch_bounds__(256) void k_wt(const float* __restrict__ W, const float* __restrict__ W2, int K, int Nsrc, bf16_t* __restrict__ out) {
    __shared__ float t[32][33];
    const int n0 = blockIdx.x * 32, k0 = blockIdx.y * 32, tx = threadIdx.x & 31, ty = threadIdx.x >> 5;
    const float* src = W; int col = n0 + tx;
    if (MAP == 1) { if (col >= 1536) col += 8; }
    if (MAP == 2) { if (col >= DFF) { src = W2; col -= DFF; } }
    for (int i = ty; i < 32; i += 8) t[i][tx] = src[(size_t)(k0 + i) * Nsrc + col];
    __syncthreads();
    for (int i = ty; i < 32; i += 8) out[(size_t)(n0 + i) * K + k0 + tx] = (bf16_t)f2bf(t[tx][i]);
}

template <int WHICH> __global__ __launch_bounds__(256) void k_norm(const float* __restrict__ x, const float* __restrict__ mod, const float* __restrict__ gain,
                                                                  const float* __restrict__ w_in, const float* __restrict__ b_forget, bf16_t* __restrict__ XN, float* __restrict__ logf) {
    const int lane = threadIdx.x & 63, wave = threadIdx.x >> 6, row = blockIdx.x * 4 + wave, b = row / SEQ, s = row % SEQ;
    const float* xr = x + (size_t)row * DM;
    const float* shift = mod + b * 6144 + (WHICH == 0 ? 0 : 3) * 1024;
    const float* scale = shift + 1024;
    f32x4 v[4]; float ss = 0.f;
#pragma unroll
    for (int j = 0; j < 4; ++j) { v[j] = *(const f32x4*)(xr + 256 * j + 4 * lane); ss += (v[j][0] * v[j][0] + v[j][1] * v[j][1]) + (v[j][2] * v[j][2] + v[j][3] * v[j][3]); }
    ss = wave_sum(ss);
    const float rstd = 1.0f / sqrtf(ss * (1.0f / DM) + EPS);
    float ff[8] = {0.f, 0.f, 0.f, 0.f, 0.f, 0.f, 0.f, 0.f};
#pragma unroll
    for (int j = 0; j < 4; ++j) {
        const int k = 256 * j + 4 * lane;
        const f32x4 g = *(const f32x4*)(gain + k), sc = *(const f32x4*)(scale + k), sh = *(const f32x4*)(shift + k);
        f32x4 h;
#pragma unroll
        for (int e = 0; e < 4; ++e) h[e] = (v[j][e] * rstd * g[e]) * (1.f + sc[e]) + sh[e];
        u32x2 w; w.x = pk2(h[0], h[1]); w.y = pk2(h[2], h[3]);
        *(u32x2*)(XN + (size_t)row * DM + k) = w;
        if (WHICH == 0) {
#pragma unroll
            for (int e = 0; e < 4; ++e) {
                const float* wr = w_in + (size_t)(k + e) * INC + 1536;
                const f32x4 w0 = *(const f32x4*)wr, w1 = *(const f32x4*)(wr + 4);
                ff[0] += h[e] * w0[0]; ff[1] += h[e] * w0[1]; ff[2] += h[e] * w0[2]; ff[3] += h[e] * w0[3];
                ff[4] += h[e] * w1[0]; ff[5] += h[e] * w1[1]; ff[6] += h[e] * w1[2]; ff[7] += h[e] * w1[3];
            }
        }
    }
    if (WHICH == 0) {
        float mine = 0.f;
#pragma unroll
        for (int hh = 0; hh < 8; ++hh) { const float t = wave_sum(ff[hh]); if (lane == hh) mine = t; }
        if (lane < 8) {
            const float z = mine + b_forget[lane];
            const float ls = fminf(z, 0.f) - log1pf(expf(-fabsf(z)));
            logf[((size_t)(b * 8 + lane)) * SEQ + s] = ls;
        }
    }
}

__global__ __launch_bounds__(256) void k_scan(const float* __restrict__ logf, float* __restrict__ Fl2) {
    __shared__ double part[256];
    const int tid = threadIdx.x; const float* src = logf + (size_t)blockIdx.x * SEQ + tid * 16;
    double run = 0.0; double loc[16];
#pragma unroll
    for (int i = 0; i < 16; ++i) { run += (double)src[i]; loc[i] = run; }
    part[tid] = run; __syncthreads();
    double off = 0.0; for (int i = 0; i < tid; ++i) off += part[i];
    float* dst = Fl2 + (size_t)blockIdx.x * SEQ + tid * 16;
#pragma unroll
    for (int i = 0; i < 16; ++i) dst[i] = (float)((off + loc[i]) * 1.4426950408889634);
}

struct EpiArgs {
    bf16_t* obf; float* of32; const float* x; const float* mod; const float* g_qf; const float* g_kf; const float* g_qm; const float* g_km; float* kmp;
};
template <int EPI> __global__ __launch_bounds__(256) void k_gemm(const bf16_t* __restrict__ A, const bf16_t* __restrict__ Bt, int K, EpiArgs e) {
    const int tid = threadIdx.x, lane = tid & 63, wave = tid >> 6, wr = wave >> 1, wc = wave & 1, fr = lane & 15, fq = lane >> 4;
    const int row0 = blockIdx.y * 128 + wr * 64, col0 = blockIdx.x * 128 + wc * 64;
    f32x4 acc[4][4], acc2[4][4];
#pragma unroll
    for (int i = 0; i < 4; ++i)
#pragma unroll
        for (int j = 0; j < 4; ++j) { acc[i][j] = (f32x4){0.f, 0.f, 0.f, 0.f}; acc2[i][j] = (f32x4){0.f, 0.f, 0.f, 0.f}; }
    const bf16_t* Ap = A + (size_t)(row0 + fr) * K + 8 * fq;
    const bf16_t* Bp = Bt + (size_t)(col0 + fr) * K + 8 * fq;
    for (int k0 = 0; k0 < K; k0 += 32) {
        bf16x8 a[4], b[4];
#pragma unroll
        for (int i = 0; i < 4; ++i) a[i] = *(const bf16x8*)(Ap + (size_t)(16 * i) * K + k0);
#pragma unroll
        for (int j = 0; j < 4; ++j) b[j] = *(const bf16x8*)(Bp + (size_t)(16 * j) * K + k0);
#pragma unroll
        for (int i = 0; i < 4; ++i)
#pragma unroll
            for (int j = 0; j < 4; ++j) acc[i][j] = __builtin_amdgcn_mfma_f32_16x16x32_bf16(b[j], a[i], acc[i][j], 0, 0, 0);
        if (EPI == 2) {
#pragma unroll
            for (int j = 0; j < 4; ++j) b[j] = *(const bf16x8*)(Bp + (size_t)(DFF + 16 * j) * K + k0);
#pragma unroll
            for (int i = 0; i < 4; ++i)
#pragma unroll
                for (int j = 0; j < 4; ++j) acc2[i][j] = __builtin_amdgcn_mfma_f32_16x16x32_bf16(b[j], a[i], acc2[i][j], 0, 0, 0);
        }
    }
    if (EPI == 0) {
        const int ct = col0 >> 6, sec = ct >> 3, head = ct & 7;
        const bool nrm = (sec == 0 || sec == 1 || sec == 3 || sec == 4);
        const float* gp = sec == 0 ? e.g_qf : sec == 1 ? e.g_kf : sec == 3 ? e.g_qm : e.g_km;
        const float qs = (sec == 0 || sec == 3) ? C2 : 1.f;
        f32x4 gv[4];
#pragma unroll
        for (int j = 0; j < 4; ++j) gv[j] = nrm ? *(const f32x4*)(gp + 16 * j + 4 * fq) * qs : (f32x4){1.f, 1.f, 1.f, 1.f};
        f32x4 csum[4];
#pragma unroll
        for (int j = 0; j < 4; ++j) csum[j] = (f32x4){0.f, 0.f, 0.f, 0.f};
#pragma unroll
        for (int i = 0; i < 4; ++i) {
            float rinv = 1.f;
            if (nrm) {
                float ss = 0.f;
#pragma unroll
                for (int j = 0; j < 4; ++j) ss += (acc[i][j][0] * acc[i][j][0] + acc[i][j][1] * acc[i][j][1]) + (acc[i][j][2] * acc[i][j][2] + acc[i][j][3] * acc[i][j][3]);
                ss += __shfl_xor(ss, 16); ss += __shfl_xor(ss, 32);
                rinv = 1.0f / sqrtf(ss * (1.0f / 64.0f) + EPS);
            }
            const size_t ro = (size_t)(row0 + 16 * i + fr) * NQKV + col0 + 4 * fq;
#pragma unroll
            for (int j = 0; j < 4; ++j) {
                const f32x4 v = acc[i][j] * rinv * gv[j];
                csum[j] += v;
                u32x2 w; w.x = pk2(v[0], v[1]); w.y = pk2(v[2], v[3]);
                *(u32x2*)(e.obf + ro + 16 * j) = w;
            }
        }
        if (sec == 4) {
            const int b = row0 / SEQ, chunk = (row0 % SEQ) >> 6;
#pragma unroll
            for (int j = 0; j < 4; ++j)
#pragma unroll
                for (int r = 0; r < 4; ++r) { float s = csum[j][r]; s += __shfl_xor(s, 1); s += __shfl_xor(s, 2); s += __shfl_xor(s, 4); s += __shfl_xor(s, 8); csum[j][r] = s; }
            if (fr == 0) {
                float* dst = e.kmp + (((size_t)(b * 8 + head)) * 64 + chunk) * 64 + 4 * fq;
#pragma unroll
                for (int j = 0; j < 4; ++j) *(f32x4*)(dst + 16 * j) = csum[j];
            }
        }
    } else if (EPI == 1 || EPI == 3) {
        const int b = row0 / SEQ;
        const float* gate = e.mod + b * 6144 + (EPI == 1 ? 2 : 5) * 1024 + col0 + 4 * fq;
#pragma unroll
        for (int i = 0; i < 4; ++i) {
            const size_t ro = (size_t)(row0 + 16 * i + fr) * DM + col0 + 4 * fq;
#pragma unroll
            for (int j = 0; j < 4; ++j) {
                const f32x4 g = *(const f32x4*)(gate + 16 * j), xv = *(const f32x4*)(e.x + ro + 16 * j);
                *(f32x4*)(e.of32 + ro + 16 * j) = xv + g * acc[i][j];
            }
        }
    } else {
#pragma unroll
        for (int i = 0; i < 4; ++i) {
            const size_t ro = (size_t)(row0 + 16 * i + fr) * DFF + col0 + 4 * fq;
#pragma unroll
            for (int j = 0; j < 4; ++j) {
                f32x4 h;
#pragma unroll
                for (int r = 0; r < 4; ++r) { const float g = acc[i][j][r]; h[r] = (g / (1.f + expf(-g))) * acc2[i][j][r]; }
                u32x2 w; w.x = pk2(h[0], h[1]); w.y = pk2(h[2], h[3]);
                *(u32x2*)(e.obf + ro + 16 * j) = w;
            }
        }
    }
}

__global__ __launch_bounds__(256) void k_sel(const bf16_t* __restrict__ QKV, const float* __restrict__ kmp, int* __restrict__ sel) {
    __shared__ float km[16][64];
    const int u = blockIdx.x, qb = u & 15, bh = u >> 4, b = bh >> 3, h = bh & 7, tid = threadIdx.x;
    for (int i = tid; i < 16 * 64; i += 256) {
        const int n = i >> 6, d = i & 63; const float* p = kmp + (((size_t)bh) * 64 + 4 * n) * 64 + d;
        km[n][d] = (p[0] + p[64]) + (p[128] + p[192]);
    }
    __syncthreads();
    const int s = qb * 256 + tid;
    const bf16_t* qp = QKV + (size_t)(b * SEQ + s) * NQKV + 1536 + h * 64;
    float g[16];
#pragma unroll
    for (int n = 0; n < 16; ++n) g[n] = 0.f;
    for (int d0 = 0; d0 < 64; d0 += 8) {
        const u32x4 w = *(const u32x4*)(qp + d0);
        float q[8] = {bf2f(w.x & 0xffffu), bf2f(w.x >> 16), bf2f(w.y & 0xffffu), bf2f(w.y >> 16), bf2f(w.z & 0xffffu), bf2f(w.z >> 16), bf2f(w.w & 0xffffu), bf2f(w.w >> 16)};
#pragma unroll
        for (int n = 0; n < 16; ++n)
#pragma unroll
            for (int e2 = 0; e2 < 8; ++e2) g[n] += q[e2] * km[n][d0 + e2];
    }
    unsigned mask = 1u << qb;
#pragma unroll
    for (int pick = 0; pick < 3; ++pick) {
        float best = -3.0e38f; int bi = -1;
#pragma unroll
        for (int n = 0; n < 16; ++n) { const bool ok = (n < qb) && !((mask >> n) & 1u); if (ok && g[n] > best) { best = g[n]; bi = n; } }
        if (bi >= 0) mask |= 1u << bi;
    }
    sel[(size_t)bh * SEQ + s] = (int)mask;
}

template <int MODE> __global__ __launch_bounds__(256) void k_attn(const bf16_t* __restrict__ QKV, const float* __restrict__ Fl2, const int* __restrict__ sel, const float* __restrict__ relb, bf16_t* __restrict__ ATT) {
    __shared__ float Ks[64][64];
    __shared__ float Vs[64][64];
    __shared__ float kb[64];
    __shared__ float tab[128];
    const int tid = threadIdx.x, u = blockIdx.x, qb = 15 - (u >> 6), bh = u & 63, b = bh >> 3, h = bh & 7;
    const int qoff = (MODE == 0 ? 0 : 1536) + h * 64, koff = qoff + 512, voff = qoff + 1024;
    const int qpos = qb * 256 + tid;
    if (MODE == 1) { if (tid < 128) tab[tid] = relb[T5B[tid] * 8 + h] * LOG2E; }
    float q[64], o[64];
    {
        const bf16_t* qp = QKV + (size_t)(b * SEQ + qpos) * NQKV + qoff;
#pragma unroll
        for (int d0 = 0; d0 < 64; d0 += 8) {
            const u32x4 w = *(const u32x4*)(qp + d0);
            q[d0] = bf2f(w.x & 0xffffu); q[d0 + 1] = bf2f(w.x >> 16); q[d0 + 2] = bf2f(w.y & 0xffffu); q[d0 + 3] = bf2f(w.y >> 16);
            q[d0 + 4] = bf2f(w.z & 0xffffu); q[d0 + 5] = bf2f(w.z >> 16); q[d0 + 6] = bf2f(w.w & 0xffffu); q[d0 + 7] = bf2f(w.w >> 16);
        }
    }
#pragma unroll
    for (int d = 0; d < 64; ++d) o[d] = 0.f;
    float m = -1.0e30f, l = 0.f;
    const unsigned smask = (MODE == 1) ? (unsigned)sel[(size_t)bh * SEQ + qpos] : 0xffffffffu;
    const int NT = 4 * (qb + 1);
    for (int t = 0; t < NT; ++t) {
        __syncthreads();
        {
            const int r = tid >> 2, sg = tid & 3;
            const bf16_t* kp = QKV + (size_t)(b * SEQ + 64 * t + r) * NQKV + koff + sg * 16;
            const bf16_t* vp = QKV + (size_t)(b * SEQ + 64 * t + r) * NQKV + voff + sg * 16;
#pragma unroll
            for (int hlf = 0; hlf < 2; ++hlf) {
                const u32x4 w = *(const u32x4*)(kp + 8 * hlf), w2 = *(const u32x4*)(vp + 8 * hlf);
                float* kd = &Ks[r][sg * 16 + 8 * hlf]; float* vd = &Vs[r][sg * 16 + 8 * hlf];
                kd[0] = bf2f(w.x & 0xffffu); kd[1] = bf2f(w.x >> 16); kd[2] = bf2f(w.y & 0xffffu); kd[3] = bf2f(w.y >> 16);
                kd[4] = bf2f(w.z & 0xffffu); kd[5] = bf2f(w.z >> 16); kd[6] = bf2f(w.w & 0xffffu); kd[7] = bf2f(w.w >> 16);
                vd[0] = bf2f(w2.x & 0xffffu); vd[1] = bf2f(w2.x >> 16); vd[2] = bf2f(w2.y & 0xffffu); vd[3] = bf2f(w2.y >> 16);
                vd[4] = bf2f(w2.z & 0xffffu); vd[5] = bf2f(w2.z >> 16); vd[6] = bf2f(w2.w & 0xffffu); vd[7] = bf2f(w2.w >> 16);
            }
            if (MODE == 0 && tid < 64) kb[tid] = -Fl2[(size_t)bh * SEQ + 64 * t + tid];
        }
        __syncthreads();
        const bool blk_ok = (MODE == 0) ? true : (((smask >> (t >> 2)) & 1u) != 0u);
        for (int c0 = 0; c0 < 64; c0 += 16) {
            float sc[16]; float cm = -1.0e30f;
#pragma unroll
            for (int j = 0; j < 16; ++j) {
                float a = 0.f;
#pragma unroll
                for (int d = 0; d < 64; d += 4) { const f32x4 kv = *(const f32x4*)&Ks[c0 + j][d]; a += q[d] * kv[0]; a += q[d + 1] * kv[1]; a += q[d + 2] * kv[2]; a += q[d + 3] * kv[3]; }
                const int kpos = 64 * t + c0 + j, dist = qpos - kpos;
                if (MODE == 0) a += kb[c0 + j]; else a += tab[dist < 0 ? 0 : (dist > 127 ? 127 : dist)];
                if (dist < 0 || !blk_ok) a = -1.0e30f;
                sc[j] = a; cm = fmaxf(cm, a);
            }
            const float mn = fmaxf(m, cm), alpha = exp2f(m - mn);
            m = mn; l *= alpha;
#pragma unroll
            for (int d = 0; d < 64; ++d) o[d] *= alpha;
#pragma unroll
            for (int j = 0; j < 16; ++j) {
                const float p = exp2f(sc[j] - mn); l += p;
#pragma unroll
                for (int d = 0; d < 64; d += 4) { const f32x4 vv = *(const f32x4*)&Vs[c0 + j][d]; o[d] += p * vv[0]; o[d + 1] += p * vv[1]; o[d + 2] += p * vv[2]; o[d + 3] += p * vv[3]; }
            }
        }
    }
    const float il = 1.0f / l;
    bf16_t* op = ATT + (size_t)(b * SEQ + qpos) * DM + (MODE == 0 ? 0 : 512) + h * 64;
#pragma unroll
    for (int d0 = 0; d0 < 64; d0 += 8) {
        u32x4 w; w.x = pk2(o[d0] * il, o[d0 + 1] * il); w.y = pk2(o[d0 + 2] * il, o[d0 + 3] * il); w.z = pk2(o[d0 + 4] * il, o[d0 + 5] * il); w.w = pk2(o[d0 + 6] * il, o[d0 + 7] * il);
        *(u32x4*)(op + d0) = w;
    }
}

extern "C" void kernel_launch(void* const* d_in, const int* in_sizes, int n_in, void* d_out, int out_size, void* d_ws, size_t ws_size, hipStream_t stream) {
    const float* x = (const float*)d_in[0]; const float* c = (const float*)d_in[1]; const float* w_ada = (const float*)d_in[2]; const float* b_ada = (const float*)d_in[3];
    const float* norm1 = (const float*)d_in[4]; const float* norm2 = (const float*)d_in[5]; const float* w_in = (const float*)d_in[6]; const float* b_forget = (const float*)d_in[7];
    const float* qnf = (const float*)d_in[8]; const float* knf = (const float*)d_in[9]; const float* qnm = (const float*)d_in[10]; const float* knm = (const float*)d_in[11];
    const float* relb = (const float*)d_in[12]; const float* w_o = (const float*)d_in[13]; const float* w_gate = (const float*)d_in[14]; const float* w_up = (const float*)d_in[15]; const float* w_down = (const float*)d_in[16];
    unsigned char* ws = (unsigned char*)d_ws; float* out = (float*)d_out;
    float* mod = (float*)(ws + WS_MOD); float* logf = (float*)(ws + WS_LOGF); float* Fl2 = (float*)(ws + WS_FL2); int* sel = (int*)(ws + WS_SEL); float* kmp = (float*)(ws + WS_KMP);
    bf16_t* Wt_in = (bf16_t*)(ws + WS_WIN); bf16_t* Wt_o = (bf16_t*)(ws + WS_WO); bf16_t* Wt_gu = (bf16_t*)(ws + WS_WGU); bf16_t* Wt_dn = (bf16_t*)(ws + WS_WDN);
    bf16_t* XN = (bf16_t*)(ws + WS_XN); bf16_t* QKV = (bf16_t*)(ws + WS_QKV); bf16_t* Hb = (bf16_t*)(ws + WS_H); bf16_t* ATT = (bf16_t*)(ws + WS_ATT);

    k_mod<<<96, 256, 0, stream>>>(c, w_ada, b_ada, mod);
    k_wt<1><<<dim3(NQKV / 32, DM / 32), 256, 0, stream>>>(w_in, nullptr, DM, INC, Wt_in);
    k_wt<0><<<dim3(DM / 32, DM / 32), 256, 0, stream>>>(w_o, nullptr, DM, DM, Wt_o);
    k_wt<2><<<dim3(2 * DFF / 32, DM / 32), 256, 0, stream>>>(w_gate, w_up, DM, DFF, Wt_gu);
    k_wt<0><<<dim3(DM / 32, DFF / 32), 256, 0, stream>>>(w_down, nullptr, DFF, DM, Wt_dn);
    k_norm<0><<<MROWS / 4, 256, 0, stream>>>(x, mod, norm1, w_in, b_forget, XN, logf);
    k_scan<<<64, 256, 0, stream>>>(logf, Fl2);
    EpiArgs e{}; e.obf = QKV; e.of32 = nullptr; e.x = x; e.mod = mod; e.g_qf = qnf; e.g_kf = knf; e.g_qm = qnm; e.g_km = knm; e.kmp = kmp;
    k_gemm<0><<<dim3(NQKV / 128, MROWS / 128), 256, 0, stream>>>(XN, Wt_in, DM, e);
    k_sel<<<64 * 16, 256, 0, stream>>>(QKV, kmp, sel);
    k_attn<0><<<1024, 256, 0, stream>>>(QKV, Fl2, sel, relb, ATT);
    k_attn<1><<<1024, 256, 0, stream>>>(QKV, Fl2, sel, relb, ATT);
    e.obf = nullptr; e.of32 = out; e.x = x;
    k_gemm<1><<<dim3(DM / 128, MROWS / 128), 256, 0, stream>>>(ATT, Wt_o, DM, e);
    k_norm<1><<<MROWS / 4, 256, 0, stream>>>(out, mod, norm2, nullptr, nullptr, XN, nullptr);
    e.obf = Hb;
    k_gemm<2><<<dim3(DFF / 128, MROWS / 128), 256, 0, stream>>>(XN, Wt_gu, DM, e);
    e.obf = nullptr; e.of32 = out; e.x = out;
    k_gemm<3><<<dim3(DM / 128, MROWS / 128), 256, 0, stream>>>(Hb, Wt_dn, DFF, e);
}
```

```cpp
#include <hip/hip_runtime.h>
#include <hip/hip_cooperative_groups.h>
#include <cstdio>
#include <cstdint>
namespace cg = cooperative_groups;
#ifndef X1_BF16
#define X1_BF16 1
#endif
#define NT_X 1
#define NT_RL 1
#define NT_P0 1
#define NT_Q 1

constexpr int NB = 8, SEQ = 4096, DM = 1024, MROWS = NB * SEQ, DH = 64, INC = 3080, DFF = 2816, NQKV = 3072, NGU = 2 * DFF;
constexpr float EPS = 1e-6f;
constexpr float LOG2E = 1.4426950408889634f;
constexpr float QSCALE = 0.125f * LOG2E;
constexpr size_t MiB = 1u << 20;
constexpr size_t WS_MOD = 0;
constexpr size_t WS_C2 = 256 * 1024;
constexpr size_t WS_GT = 448 * 1024;
constexpr size_t WS_T0 = 452 * 1024;
constexpr size_t WS_CTL = 512 * 1024, CTL_BYTES = 32768;
constexpr size_t WS_LOGF = 1 * MiB;
constexpr size_t WS_FL2 = 2 * MiB;
constexpr size_t WS_KAUG = 3 * MiB;
constexpr size_t WS_KMP = 5 * MiB;
constexpr size_t WS_RSQ = 6 * MiB;
constexpr size_t WS_WIN = 8 * MiB, WS_WO = 14 * MiB, WS_WGU = 16 * MiB, WS_WDN = 28 * MiB;
constexpr size_t WS_XN = 64 * MiB;
constexpr size_t WS_QKV = 128 * MiB;
constexpr size_t WS_H = 128 * MiB;
constexpr size_t WS_ATT = 320 * MiB;
constexpr size_t WS_X1B = 448 * MiB;
constexpr size_t WS_END = 512 * MiB;

typedef float f32x4 __attribute__((ext_vector_type(4)));
typedef unsigned u32x2 __attribute__((ext_vector_type(2)));
typedef unsigned u32x4 __attribute__((ext_vector_type(4)));

__device__ const unsigned char T5B[128] = {0, 1, 2, 3, 4, 5, 6, 7, 8, 9, 10, 11, 12, 13, 14, 15, 16, 16, 16, 17, 17, 18, 18, 18, 19, 19, 19, 20, 20, 20, 20, 21, 21, 21, 21, 22, 22, 22, 22, 22, 23, 23, 23, 23, 23, 23, 24, 24, 24, 24, 24, 24, 25, 25, 25, 25, 25, 25, 25, 26, 26, 26, 26, 26, 26, 26, 26, 27, 27, 27, 27, 27, 27, 27, 27, 27, 27, 28, 28, 28, 28, 28, 28, 28, 28, 28, 28, 29, 29, 29, 29, 29, 29, 29, 29, 29, 29, 29, 29, 30, 30, 30, 30, 30, 30, 30, 30, 30, 30, 30, 30, 30, 30, 31, 31, 31, 31, 31, 31, 31, 31, 31, 31, 31, 31, 31, 31, 31};

__device__ __forceinline__ unsigned f2bf(float f) { unsigned u = __float_as_uint(f); return (u + 0x7fffu + ((u >> 16) & 1u)) >> 16; }
typedef float f32x2_hw __attribute__((ext_vector_type(2))); typedef __bf16 bf16x2_hw __attribute__((ext_vector_type(2)));
__device__ __forceinline__ unsigned pk2(float lo, float hi) { const f32x2_hw v = {lo, hi}; return __builtin_bit_cast(unsigned, __builtin_convertvector(v, bf16x2_hw)); }
__device__ __forceinline__ float bf2f(unsigned h) { return __uint_as_float(h << 16); }
template <int CTRL> __device__ __forceinline__ float dppf(float v) { return __builtin_bit_cast(float, __builtin_amdgcn_update_dpp(0, __builtin_bit_cast(int, v), CTRL, 0xf, 0xf, true)); }
__device__ __forceinline__ float lx1(float v) { return dppf<0xB1>(v); }
__device__ __forceinline__ float lx2(float v) { return dppf<0x4E>(v); }
__device__ __forceinline__ float lx4(float v, bool bit2) { const float up = dppf<0x104>(v), dn = dppf<0x114>(v); return bit2 ? dn : up; }
__device__ __forceinline__ float lx8(float v) { return dppf<0x128>(v); }
__device__ __forceinline__ float addx16(float v) { auto r = __builtin_amdgcn_permlane16_swap(__float_as_uint(v), __float_as_uint(v), false, false); return __uint_as_float(r[0]) + __uint_as_float(r[1]); }
__device__ __forceinline__ float addx32(float v) { auto r = __builtin_amdgcn_permlane32_swap(__float_as_uint(v), __float_as_uint(v), false, false); return __uint_as_float(r[0]) + __uint_as_float(r[1]); }
__device__ __forceinline__ float wave_sum(float v) {
    v += lx1(v); v += lx2(v); v += dppf<0x141>(v)  ; v += dppf<0x140>(v)  ; v = addx16(v); v = addx32(v);
    return v;
}
#ifndef PG8_WGM
#define PG8_WGM 4
#endif
namespace pg8 {
#define PG8_LAS __attribute__((address_space(3)))
typedef unsigned short bf16_t;
typedef short bf16x8 __attribute__((ext_vector_type(8)));
typedef float f32x4 __attribute__((ext_vector_type(4)));
typedef unsigned u32x4 __attribute__((ext_vector_type(4)));
constexpr int BM = 256, BK = 64, HALF = 128, HTB = HALF * BK * 2  , STAGE_BYTES = 8 * HTB, NXCD = 8, WGM = PG8_WGM;

__host__ __device__ __forceinline__ int lds_byte(int r, int c) { const int st = (r >> 4) * 2 + (c >> 5), rr = r & 15, cc = c & 31, ob = rr * 64 + cc * 2; return st * 1024 + (ob ^ (((ob >> 9) & 1) << 5)); }
__host__ __device__ __forceinline__ void stage_rc(int b, int& R, int& C) { const int st = b / 1024, sb = b % 1024, swz = sb ^ (((sb >> 9) & 1) << 5); R = (st >> 1) * 16 + swz / 64; C = (st & 1) * 32 + (swz % 64) / 2; }
__host__ __device__ __forceinline__ int perm32(int rho) { const int n = rho >> 4, i = rho & 15; return 8 * (i >> 2) + 4 * n + (i & 3); }

struct Unit { int pm, pn; };
struct Gemm { const bf16_t* A; const bf16_t* Bt; int M, N, K; };

struct StaticOrder {
    int nM, nN, nwg, G, c;
    __host__ __device__ void init(int M, int N, int G_, int c_) { nM = M / BM; nN = N / BM; nwg = nM * nN; G = G_; c = c_; }
    __host__ __device__ bool next(int i, Unit& u) const {
        const long L = (long)i * G + c; if (L >= nwg) return false;
        int wgid = (int)L; { const int q = nwg / NXCD, r = nwg % NXCD, xcd = wgid % NXCD, off = wgid / NXCD; wgid = (xcd < r ? xcd * (q + 1) : r * (q + 1) + (xcd - r) * q) + off; }
        const int nig = WGM * nN, gid = wgid / nig, fm = gid * WGM, gsz = (nM - fm) < WGM ? (nM - fm) : WGM;
        u.pm = fm + ((wgid % nig) % gsz); u.pn = (wgid % nig) / gsz; return true;
    }
    __device__ __forceinline__ void a_ready(const Unit&) const {}
    __device__ __forceinline__ void done(const Unit&) const {}
};
__device__ __forceinline__ unsigned cvt_pk_bf16(float lo, float hi) { unsigned r; asm volatile("v_cvt_pk_bf16_f32 %0, %1, %2" : "=v"(r) : "v"(lo), "v"(hi)); return r; }
typedef float f32x2 __attribute__((ext_vector_type(2)));
#ifdef NT_X
#define LDXE(p) __builtin_nontemporal_load((const f32x4*)(p))
#else
#define LDXE(p) (*(const f32x4*)(p))
#endif
#ifdef NT_RL
#define NT_LD16(p) __builtin_nontemporal_load((const u32x4*)(p))
#else
#define NT_LD16(p) (*(const u32x4*)(p))
#endif
#ifdef NT_RS
#define NT_ST16(p, v) __builtin_nontemporal_store((v), (u32x4*)(p))
#else
#define NT_ST16(p, v) (*(u32x4*)(p) = (v))
#endif
#ifdef NT_RO
#define NT_ST16F(p, v) __builtin_nontemporal_store((v), (f32x4*)(p))
#else
#define NT_ST16F(p, v) (*(f32x4*)(p) = (v))
#endif
struct EpiInProj {
    static constexpr bool PERM = true, AFTER_DRAIN = false, PRELOAD = false; static constexpr int NSTORE = 16;
    bf16_t* O; const float* gtab; float* kmp;
    __device__ __forceinline__ void operator()(const f32x4 (&acc)[2][2][4][2], const Unit& u, int wr, int wc, int fr, int fq) const {
        const int sec = u.pn >> 1, head = 4 * (u.pn & 1) + wc;
        const bool nrm = (sec != 2 && sec != 5);
        const float* gp = gtab + 64 * (sec - (sec >= 3 ? 1 : 0));
        const float qs = (sec == 0 || sec == 3) ? QSCALE : 1.f;
        f32x4 gv[2][2]; float rinvs[2][4];
#pragma unroll
        for (int bj = 0; bj < 2; ++bj)
#pragma unroll
            for (int n = 0; n < 2; ++n) gv[bj][n] = nrm ? *(const f32x4*)(gp + 32 * bj + 8 * fq + 4 * n) * qs : (f32x4){1.f, 1.f, 1.f, 1.f};
        bf16_t* obase = O + (size_t)(u.pm * BM + wr * 64 + fr) * NQKV + 512 * sec + 64 * head + 8 * fq;
#pragma unroll
        for (int ai = 0; ai < 2; ++ai)
#pragma unroll
            for (int m = 0; m < 4; ++m) {
                float rinv = 1.f;
                if (nrm) {
                    typedef float f32x2_ __attribute__((ext_vector_type(2)));
                    f32x2_ s2 = {0.f, 0.f}, s3 = {0.f, 0.f};
#pragma unroll
                    for (int bj = 0; bj < 2; ++bj)
#pragma unroll
                        for (int n = 0; n < 2; ++n) { const f32x4 v = acc[ai][bj][m][n]; const f32x2_ a = {v[0], v[1]}, b = {v[2], v[3]}; s2 = __builtin_elementwise_fma(a, a, s2); s3 = __builtin_elementwise_fma(b, b, s3); }
                    float ss = (s2.x + s2.y) + (s3.x + s3.y);
                    ss = ::addx16(ss); ss = ::addx32(ss);
                    rinv = __builtin_amdgcn_rsqf(ss * (1.0f / 64.0f) + EPS);
                }
                rinvs[ai][m] = rinv;
                bf16_t* rowp = obase + (size_t)(ai * HALF + m * 16) * NQKV;
#pragma unroll
                for (int bj = 0; bj < 2; ++bj) {
                    const f32x4 v0 = acc[ai][bj][m][0] * rinv * gv[bj][0], v1 = acc[ai][bj][m][1] * rinv * gv[bj][1];
                    u32x4 w; w.x = cvt_pk_bf16(v0[0], v0[1]); w.y = cvt_pk_bf16(v0[2], v0[3]); w.z = cvt_pk_bf16(v1[0], v1[1]); w.w = cvt_pk_bf16(v1[2], v1[3]);
                    *(u32x4*)(rowp + 32 * bj) = w;
                }
            }
        if (sec == 4) {
            const int b = u.pm >> 4, nblk = u.pm & 15;
            float* dst = kmp + ((size_t)(((b * 8 + head) * 16 + nblk) * 2 + wr)) * 64 + 8 * fq;
#pragma unroll
            for (int bj = 0; bj < 2; ++bj)
#pragma unroll
                for (int n = 0; n < 2; ++n) {
                    f32x4 cs = (f32x4){0.f, 0.f, 0.f, 0.f};
#pragma unroll
                    for (int ai = 0; ai < 2; ++ai)
#pragma unroll
                        for (int m = 0; m < 4; ++m) cs += acc[ai][bj][m][n] * rinvs[ai][m];
                    cs *= gv[bj][n];
#pragma unroll
                    for (int e = 0; e < 4; ++e) { float t = cs[e]; t += ::lx1(t); t += ::lx2(t); t += ::dppf<0x141>(t); t += ::dppf<0x140>(t); cs[e] = t; }
                    if (fr == 0) *(f32x4*)(dst + 32 * bj + 4 * n) = cs;
                }
        }
    }
};
struct EpiWo {
    static constexpr bool PERM = true, AFTER_DRAIN = false, PRELOAD = false; static constexpr int NSTORE = 18;
    const float* x; float* out; bf16_t* xn; const float* mod; const float* norm2; float* rsq; bf16_t* x1b;
    __device__ __forceinline__ void operator()(const f32x4 (&acc)[2][2][4][2], const Unit& u, int wr, int wc, int fr, int fq) const {
        const int b = u.pm >> 4, col0 = u.pn * BM + wc * 32 + 8 * fq;
        f32x4 g1[2][2], gm[2][2];
#pragma unroll
        for (int bj = 0; bj < 2; ++bj)
#pragma unroll
            for (int n = 0; n < 2; ++n) { const int c = col0 + bj * HALF + 4 * n;
                g1[bj][n] = *(const f32x4*)(mod + b * 6144 + 2 * 1024 + c);
                gm[bj][n] = *(const f32x4*)(norm2 + c) * (*(const f32x4*)(mod + b * 6144 + 4 * 1024 + c) + 1.0f); }
#pragma unroll
        for (int am = 0; am < 8; am += 2) {
            f32x4 xv[2][2][2];
#pragma unroll
            for (int q = 0; q < 2; ++q) { const int ai = (am + q) >> 2, m = (am + q) & 3; const size_t off = (size_t)(u.pm * BM + ai * HALF + wr * 64 + m * 16 + fr) * DM + col0;
#pragma unroll
                for (int bj = 0; bj < 2; ++bj)
#pragma unroll
                    for (int n = 0; n < 2; ++n) xv[q][bj][n] = LDXE(x + off + bj * HALF + 4 * n); }
            asm volatile("" ::: "memory");
#pragma unroll
            for (int q = 0; q < 2; ++q) {
                const int ai = (am + q) >> 2, m = (am + q) & 3;
                const int row = u.pm * BM + ai * HALF + wr * 64 + m * 16 + fr; const size_t off = (size_t)row * DM + col0; float ss = 0.f;
#pragma unroll
                for (int bj = 0; bj < 2; ++bj) {
                    const f32x4 a0 = xv[q][bj][0] + g1[bj][0] * acc[ai][bj][m][0], a1 = xv[q][bj][1] + g1[bj][1] * acc[ai][bj][m][1];
#if X1_BF16
                    { u32x4 wx; wx.x = cvt_pk_bf16(a0[0], a0[1]); wx.y = cvt_pk_bf16(a0[2], a0[3]); wx.z = cvt_pk_bf16(a1[0], a1[1]); wx.w = cvt_pk_bf16(a1[2], a1[3]); NT_ST16(x1b + off + bj * HALF, wx); }
#else
                    *(f32x4*)(out + off + bj * HALF) = a0; *(f32x4*)(out + off + bj * HALF + 4) = a1;
#endif
                    ss += ((a0[0] * a0[0] + a0[1] * a0[1]) + (a0[2] * a0[2] + a0[3] * a0[3])) + ((a1[0] * a1[0] + a1[1] * a1[1]) + (a1[2] * a1[2] + a1[3] * a1[3]));
                    const f32x4 y0 = a0 * gm[bj][0], y1 = a1 * gm[bj][1];
                    u32x4 wy; wy.x = cvt_pk_bf16(y0[0], y0[1]); wy.y = cvt_pk_bf16(y0[2], y0[3]); wy.z = cvt_pk_bf16(y1[0], y1[1]); wy.w = cvt_pk_bf16(y1[2], y1[3]);
                    *(u32x4*)(xn + off + bj * HALF) = wy;
                }
                ss = ::addx16(ss); ss = ::addx32(ss);
                if (fq == 0) rsq[(size_t)row * 16 + 4 * u.pn + wc] = ss;
            }
            asm volatile("" ::: "memory");
        }
    }
};
struct EpiSwiGLU {
    static constexpr bool PERM = true, AFTER_DRAIN = false, PRELOAD = true; static constexpr int NSTORE = 8;
    bf16_t* H; const float* c2; const float* rsq; PG8_LAS unsigned char* ext;
    __device__ __forceinline__ void preload(const Unit& u, int wid, int lane) const {
        const char* src = (const char*)(rsq + (size_t)u.pm * BM * 16) + lane * 16;
#pragma unroll
        for (int i = 0; i < 2; ++i) { const int pc = wid * 2 + i; __builtin_amdgcn_global_load_lds((const unsigned*)(src + pc * 1024), (PG8_LAS unsigned*)(ext + pc * 1024), 16, 0, 0); }
        if (wid == 0) __builtin_amdgcn_global_load_lds((const unsigned*)((const char*)(c2 + (u.pm >> 4) * NGU + u.pn * 256) + lane * 16), (PG8_LAS unsigned*)(ext + 16384), 16, 0, 0);
    }
    __device__ __forceinline__ void operator()(const f32x4 (&acc)[2][2][4][2], const Unit& u, int wr, int wc, int fr, int fq) const {
        const int hc = u.pn * 128 + wc * 32 + 8 * fq;
        f32x4 cg[2], cu[2];
        { const PG8_LAS float* cl = (const PG8_LAS float*)(ext + 16384) + wc * 32 + 8 * fq;
#pragma unroll
        for (int n = 0; n < 2; ++n) { cg[n] = *(const PG8_LAS f32x4*)(cl + 4 * n); cu[n] = *(const PG8_LAS f32x4*)(cl + 128 + 4 * n); } }
        f32x4 cgn[2]; cgn[0] = cg[0] * (-LOG2E); cgn[1] = cg[1] * (-LOG2E);
        f32x4 pr[2][4];
#pragma unroll
        for (int ai = 0; ai < 2; ++ai)
#pragma unroll
            for (int m = 0; m < 4; ++m) pr[ai][m] = *(const PG8_LAS f32x4*)(ext + (ai * HALF + wr * 64 + m * 16 + fr) * 64 + 16 * fq);
        float rstd[2][4];
#pragma unroll
        for (int ai = 0; ai < 2; ++ai)
#pragma unroll
            for (int m = 0; m < 4; ++m) { float t = (pr[ai][m][0] + pr[ai][m][1]) + (pr[ai][m][2] + pr[ai][m][3]); t = ::addx16(t); t = ::addx32(t); rstd[ai][m] = __builtin_amdgcn_rsqf(t * (1.0f / 1024.0f) + EPS); }
#pragma unroll
        for (int ai = 0; ai < 2; ++ai)
#pragma unroll
            for (int m = 0; m < 4; ++m) {
                const int row = u.pm * BM + ai * HALF + wr * 64 + m * 16 + fr;
                const float rs = rstd[ai][m], rsn = -rs * LOG2E;
                typedef float f32x2_ __attribute__((ext_vector_type(2)));
                const f32x2_ rs2 = {rs, rs}, rsn2 = {rsn, rsn};
                unsigned wq[4];
#pragma unroll
                for (int n = 0; n < 2; ++n)
#pragma unroll
                    for (int pp = 0; pp < 2; ++pp) {
                        const f32x2_ ag = {acc[ai][0][m][n][2 * pp], acc[ai][0][m][n][2 * pp + 1]}, au = {acc[ai][1][m][n][2 * pp], acc[ai][1][m][n][2 * pp + 1]};
                        const f32x2_ cgp = {cg[n][2 * pp], cg[n][2 * pp + 1]}, cup = {cu[n][2 * pp], cu[n][2 * pp + 1]}, cgnp = {cgn[n][2 * pp], cgn[n][2 * pp + 1]};
                        const f32x2_ g = __builtin_elementwise_fma(ag, rs2, cgp), uu = __builtin_elementwise_fma(au, rs2, cup), ge = __builtin_elementwise_fma(ag, rsn2, cgnp);
                        const f32x2_ e2 = {__builtin_amdgcn_exp2f(ge.x), __builtin_amdgcn_exp2f(ge.y)};
                        const f32x2_ d2 = e2 + 1.0f;
                        const f32x2_ r2 = {__builtin_amdgcn_rcpf(d2.x), __builtin_amdgcn_rcpf(d2.y)};
                        const f32x2_ hp = (g * uu) * r2;
                        wq[2 * n + pp] = cvt_pk_bf16(hp.x, hp.y);
                    }
                u32x4 w; w.x = wq[0]; w.y = wq[1]; w.z = wq[2]; w.w = wq[3];
                *(u32x4*)(H + (size_t)row * DFF + hc) = w;
            }
    }
};
struct EpiDown {
    static constexpr bool PERM = true, AFTER_DRAIN = false, PRELOAD = false; static constexpr int NSTORE = 16;
    const float* xin; float* out; const float* mod; const bf16_t* x1b;
    __device__ __forceinline__ void operator()(const f32x4 (&acc)[2][2][4][2], const Unit& u, int wr, int wc, int fr, int fq) const {
        const int b = u.pm >> 4, col0 = u.pn * BM + wc * 32 + 8 * fq;
        f32x4 g2[2][2];
#pragma unroll
        for (int bj = 0; bj < 2; ++bj)
#pragma unroll
            for (int n = 0; n < 2; ++n) g2[bj][n] = *(const f32x4*)(mod + b * 6144 + 5 * 1024 + col0 + bj * HALF + 4 * n);
#pragma unroll
        for (int ai = 0; ai < 2; ++ai) {
            f32x4 xv[4][2][2];
#pragma unroll
            for (int m = 0; m < 4; ++m) { const size_t off = (size_t)(u.pm * BM + ai * HALF + wr * 64 + m * 16 + fr) * DM + col0;
#pragma unroll
                for (int bj = 0; bj < 2; ++bj) {
#if X1_BF16
                    const u32x4 wx = NT_LD16(x1b + off + bj * HALF);
                    xv[m][bj][0] = (f32x4){__uint_as_float(wx.x << 16), __uint_as_float(wx.x & 0xffff0000u), __uint_as_float(wx.y << 16), __uint_as_float(wx.y & 0xffff0000u)};
                    xv[m][bj][1] = (f32x4){__uint_as_float(wx.z << 16), __uint_as_float(wx.z & 0xffff0000u), __uint_as_float(wx.w << 16), __uint_as_float(wx.w & 0xffff0000u)};
#else
                    xv[m][bj][0] = *(const f32x4*)(xin + off + bj * HALF); xv[m][bj][1] = *(const f32x4*)(xin + off + bj * HALF + 4);
#endif
                } }
            asm volatile("" ::: "memory");
#pragma unroll
            for (int m = 0; m < 4; ++m) { const size_t off = (size_t)(u.pm * BM + ai * HALF + wr * 64 + m * 16 + fr) * DM + col0;
#pragma unroll
                for (int bj = 0; bj < 2; ++bj)
#pragma unroll
                    for (int n = 0; n < 2; ++n) NT_ST16F(out + off + bj * HALF + 4 * n, xv[m][bj][n] + g2[bj][n] * acc[ai][bj][m][n]); }
            asm volatile("" ::: "memory");
        }
    }
};

template <class Epi, class Sched, bool ALIGN_EPI = false, bool SP2 = false>
__device__ __forceinline__ void gemm_phase(PG8_LAS unsigned char* lds, const Gemm g, const Sched& S, const Epi& E) {
    int tid_ = threadIdx.x; asm volatile("" : "+v"(tid_));
    const int tid = tid_, wid = __builtin_amdgcn_readfirstlane(tid >> 6), lane = tid & 63, wr = wid >> 2, wc = wid & 3, fr = lane & 15, fq = lane >> 4;
    const int K = g.K, nt = K / BK;
    unsigned voffA[2], voffB[2];
#pragma unroll
    for (int i = 0; i < 2; ++i) { int R, C; stage_rc(tid * 16 + i * 8192, R, C); const int Rb = Epi::PERM ? ((R & ~31) + perm32(R & 31)) : R;
        voffA[i] = (unsigned)(R * K + C) * 2u; voffB[i] = (unsigned)(Rb * K + C) * 2u; }
    const size_t kstep = (size_t)(BK * 2);
    const size_t hstep = (size_t)HALF * K * 2;
    const size_t tstep = 2 * hstep;
    const unsigned ldsw = (unsigned)wid * 1024u;
    const int aoff = lds_byte(wr * 64 + fr, fq * 8), boff = lds_byte(wc * 32 + fr, fq * 8);
#define PG8_SA(b, h) (((b) * 2 + (h)) * HTB)
#define PG8_SB(b, h) ((4 + (b) * 2 + (h)) * HTB)
#define PG8_STAGE(bufoff, gbase, voff) do { _Pragma("unroll") for (int _i = 0; _i < 2; ++_i) \
        __builtin_amdgcn_global_load_lds((const unsigned*)((const char*)(gbase) + (voff)[_i]), (PG8_LAS unsigned*)(lds + (bufoff) + ldsw + _i * 8192), 16, 0, 0); } while (0)
#define PG8_LDA(dst, b, h) do { _Pragma("unroll") for (int m = 0; m < 4; ++m) _Pragma("unroll") for (int k = 0; k < 2; ++k) dst[m][k] = *(const PG8_LAS bf16x8*)(lds + PG8_SA(b, h) + aoff + m * 2048 + k * 1024); } while (0)
#define PG8_LDB(dst, b, h) do { _Pragma("unroll") for (int n = 0; n < 2; ++n) _Pragma("unroll") for (int k = 0; k < 2; ++k) dst[n][k] = *(const PG8_LAS bf16x8*)(lds + PG8_SB(b, h) + boff + n * 2048 + k * 1024); } while (0)
#define PG8_MMA(ai, bj, At, Bt) do { __builtin_amdgcn_s_setprio(1); _Pragma("unroll") for (int m = 0; m < 4; ++m) _Pragma("unroll") for (int n = 0; n < 2; ++n) _Pragma("unroll") for (int k = 0; k < 2; ++k) \
        acc[ai][bj][m][n] = __builtin_amdgcn_mfma_f32_16x16x32_bf16(Bt[n][k], At[m][k], acc[ai][bj][m][n], 0, 0, 0); __builtin_amdgcn_s_setprio(0); } while (0)
#define PG8_WAIT_V(n) asm volatile("s_waitcnt vmcnt(" #n ")" ::: "memory")
#define PG8_WAIT_L(n) asm volatile("s_waitcnt lgkmcnt(" #n ")" ::: "memory")
#define PG8_BAR __builtin_amdgcn_s_barrier()
#define PG8_SCHED __builtin_amdgcn_sched_barrier(0)
    Unit cur, nxt; int ui = 0;
    if (!S.next(0, cur)) return;
    f32x4 acc[2][2][4][2];
#pragma unroll
    for (int a = 0; a < 2; ++a)
#pragma unroll
        for (int b = 0; b < 2; ++b)
#pragma unroll
            for (int m = 0; m < 4; ++m)
#pragma unroll
                for (int n = 0; n < 2; ++n) acc[a][b][m][n] = (f32x4){0.f, 0.f, 0.f, 0.f};
    bf16x8 At[4][2], B0[2][2], B1[2][2];
    const char* cA = (const char*)g.A + (size_t)cur.pm * tstep; const char* cB = (const char*)g.Bt + (size_t)cur.pn * tstep;
    S.a_ready(cur);
    if constexpr (SP2) {
        PG8_STAGE(PG8_SB(0, 0), cB, voffB); PG8_STAGE(PG8_SB(0, 1), cB + hstep, voffB); PG8_STAGE(PG8_SA(0, 0), cA, voffA); PG8_STAGE(PG8_SA(0, 1), cA + hstep, voffA);
        if (wr == 1) PG8_BAR;
        PG8_WAIT_V(2); PG8_BAR;
        PG8_STAGE(PG8_SB(1, 0), cB + kstep, voffB); PG8_STAGE(PG8_SA(1, 0), cA + kstep, voffA); PG8_STAGE(PG8_SB(1, 1), cB + hstep + kstep, voffB);
        PG8_WAIT_V(6); PG8_BAR;
    } else {
        PG8_STAGE(PG8_SB(0, 0), cB, voffB); PG8_STAGE(PG8_SA(0, 0), cA, voffA); PG8_STAGE(PG8_SB(0, 1), cB + hstep, voffB); PG8_STAGE(PG8_SA(0, 1), cA + hstep, voffA);
        if (wr == 1) PG8_BAR;
        PG8_WAIT_V(4); PG8_BAR;
        PG8_STAGE(PG8_SB(1, 0), cB + kstep, voffB); PG8_STAGE(PG8_SA(1, 0), cA + kstep, voffA); PG8_STAGE(PG8_SB(1, 1), cB + hstep + kstep, voffB);
        PG8_WAIT_V(6); PG8_BAR;
    }
    for (;;) {
        const bool has_next = S.next(ui + 1, nxt);
        const char* nA = has_next ? (const char*)g.A + (size_t)nxt.pm * tstep : cA; const char* nB = has_next ? (const char*)g.Bt + (size_t)nxt.pn * tstep : cB;
        for (int t = 0; t < nt; t += 2) {
            const bool last = (t == nt - 2);
            const char* a1 = cA + (size_t)(t + 1) * kstep;
            const char* a2 = last ? nA : cA + (size_t)(t + 2) * kstep; const char* b2 = last ? nB : cB + (size_t)(t + 2) * kstep;
            const char* a3 = a2 + kstep; const char* b3 = b2 + kstep;
            if (last && has_next) S.a_ready(nxt);
            if constexpr (Epi::PRELOAD) { if (t == nt - 4) E.preload(cur, wid, lane); }
            if constexpr (SP2) {
            PG8_LDB(B0, 0, 0); PG8_LDB(B1, 0, 1); PG8_SCHED; PG8_LDA(At, 0, 0); PG8_STAGE(PG8_SA(1, 1), a1 + hstep, voffA);
            PG8_WAIT_V(8); PG8_WAIT_L(0); PG8_BAR; PG8_MMA(0, 0, At, B0); PG8_MMA(0, 1, At, B1); PG8_BAR; PG8_SCHED;
            PG8_LDA(At, 0, 1); PG8_STAGE(PG8_SB(0, 0), b2, voffB); PG8_STAGE(PG8_SB(0, 1), b2 + hstep, voffB); PG8_STAGE(PG8_SA(0, 0), a2, voffA);
            PG8_WAIT_V(8); PG8_WAIT_L(0); PG8_BAR; PG8_MMA(1, 0, At, B0); PG8_MMA(1, 1, At, B1); PG8_BAR; PG8_SCHED;
            PG8_LDB(B0, 1, 0); PG8_LDB(B1, 1, 1); PG8_SCHED; PG8_LDA(At, 1, 0); PG8_STAGE(PG8_SA(0, 1), a2 + hstep, voffA);
            PG8_WAIT_V(8); PG8_WAIT_L(0); PG8_BAR; PG8_MMA(0, 0, At, B0); PG8_MMA(0, 1, At, B1); PG8_BAR; PG8_SCHED;
            PG8_LDA(At, 1, 1); PG8_STAGE(PG8_SB(1, 0), b3, voffB); PG8_STAGE(PG8_SB(1, 1), b3 + hstep, voffB); PG8_STAGE(PG8_SA(1, 0), a3, voffA);
            PG8_WAIT_V(8); PG8_WAIT_L(0); PG8_BAR; PG8_MMA(1, 0, At, B0); PG8_MMA(1, 1, At, B1); PG8_BAR; PG8_SCHED;
            } else {
            PG8_LDB(B0, 0, 0); PG8_SCHED; PG8_LDA(At, 0, 0); PG8_STAGE(PG8_SA(1, 1), a1 + hstep, voffA);
            PG8_WAIT_L(8); PG8_BAR; PG8_WAIT_L(0); PG8_MMA(0, 0, At, B0); PG8_BAR; PG8_SCHED;
            PG8_LDB(B1, 0, 1); PG8_STAGE(PG8_SB(0, 0), b2, voffB);
            PG8_BAR; PG8_WAIT_L(0); PG8_MMA(0, 1, At, B1); PG8_BAR;
            PG8_LDA(At, 0, 1); PG8_STAGE(PG8_SA(0, 0), a2, voffA);
            PG8_BAR; PG8_WAIT_L(0); PG8_MMA(1, 0, At, B0); PG8_BAR; PG8_SCHED;
            PG8_STAGE(PG8_SB(0, 1), b2 + hstep, voffB);
            PG8_WAIT_V(6); PG8_BAR; PG8_MMA(1, 1, At, B1); PG8_BAR;
            PG8_LDB(B0, 1, 0); PG8_SCHED; PG8_LDA(At, 1, 0); PG8_STAGE(PG8_SA(0, 1), a2 + hstep, voffA);
            PG8_WAIT_L(8); PG8_BAR; PG8_WAIT_L(0); PG8_MMA(0, 0, At, B0); PG8_BAR; PG8_SCHED;
            PG8_LDB(B1, 1, 1); PG8_STAGE(PG8_SB(1, 0), b3, voffB);
            PG8_BAR; PG8_WAIT_L(0); PG8_MMA(0, 1, At, B1); PG8_BAR;
            PG8_LDA(At, 1, 1); PG8_STAGE(PG8_SA(1, 0), a3, voffA);
            PG8_BAR; PG8_WAIT_L(0); PG8_MMA(1, 0, At, B0); PG8_BAR; PG8_SCHED;
            PG8_STAGE(PG8_SB(1, 1), b3 + hstep, voffB);
            PG8_WAIT_V(6); PG8_BAR; PG8_MMA(1, 1, At, B1); PG8_BAR;
            }
        }
        if constexpr (ALIGN_EPI) { if (wr == 0) PG8_BAR; }
        if constexpr (!Epi::AFTER_DRAIN) { E(acc, cur, wr, wc, fr, fq); S.done(cur); }
        if (!has_next) break;
#pragma unroll
        for (int a = 0; a < 2; ++a)
#pragma unroll
            for (int b = 0; b < 2; ++b)
#pragma unroll
                for (int m = 0; m < 4; ++m)
#pragma unroll
                    for (int n = 0; n < 2; ++n) acc[a][b][m][n] = (f32x4){0.f, 0.f, 0.f, 0.f};
        cur = nxt; cA = nA; cB = nB; ++ui;
        if constexpr (ALIGN_EPI) { if (wr == 1) PG8_BAR; }
    }
    PG8_WAIT_V(0);
    if constexpr (!ALIGN_EPI) { if (wr == 0) PG8_BAR; }
    PG8_BAR;
    if constexpr (Epi::AFTER_DRAIN) { E.fused(acc, cur, wr, wc, fr, fq, lds, wid, lane); S.done(cur); }
#undef PG8_SA
#undef PG8_SB
#undef PG8_STAGE
#undef PG8_LDA
#undef PG8_LDB
#undef PG8_MMA
#undef PG8_WAIT_V
#undef PG8_WAIT_L
#undef PG8_BAR
#undef PG8_SCHED
}
}
#include <hip/hip_bf16.h>
#ifndef SKIP_MODES
#define SKIP_MODES(M) ((M)==1)
#endif
namespace attn_body {
using bf16=__hip_bfloat16;
using bf16x8=__attribute__((ext_vector_type(8)))short;
using s16x4=__attribute__((ext_vector_type(4)))short;
using f32x16=__attribute__((ext_vector_type(16)))float;
using f32x4v=__attribute__((ext_vector_type(4)))float;
using u32x4=__attribute__((ext_vector_type(4)))unsigned;
using u32x2v=__attribute__((ext_vector_type(2)))unsigned;
constexpr int NHEAD=8,SEQ=4096,D=64,QP=3072,OP=1024;
constexpr int NW=8,QBLK=32,QB=QBLK*NW,KVBLK=64;
__device__ __forceinline__ int crow(int r,int hi){return (r&3)+8*(r>>2)+4*hi;}
#define SBAR() __builtin_amdgcn_sched_barrier(0)
typedef __attribute__((address_space(3))) const char* lds_cptr;
typedef __attribute__((address_space(3))) const float* lds_fptr;
typedef __attribute__((address_space(3))) const unsigned* lds_uptr;
__device__ __forceinline__ void cmask(f32x16&p0,f32x16&p1,int jb,int qrel,int hi){
  const float NEG=-INFINITY; int kb=64*jb+4*hi;
  #pragma unroll
  for(int r=0;r<16;++r){int kv=kb+(r&3)+8*(r>>2); if(kv>qrel)p0[r]=NEG; if(kv+32>qrel)p1[r]=NEG;}
}
__device__ __forceinline__ void bias_add(f32x16&p0,f32x16&p1,int jb,int qrel,int hi,lds_fptr tab){
  const int base=qrel-64*jb-4*hi;
  #pragma unroll
  for(int r=0;r<16;++r){const int d0=base-((r&3)+8*(r>>2)),d1=d0-32; p0[r]+=tab[d0<0?0:d0]; p1[r]+=tab[d1<0?0:d1];}
}

constexpr int NSLOT=3, SLOTB=8192;
constexpr int LDS_K=0, LDS_V=NSLOT*SLOTB, LDS_WS=2*NSLOT*SLOTB, LDS_OST=LDS_WS+NW*64*4, LDS_FAUG=LDS_OST+NW*4096, LDS_TAB=LDS_FAUG+32768, LDS_KM=LDS_TAB+1536, LDS_BYTES=LDS_KM+4096;
__device__ __forceinline__ void glds16(const void*gsrc,unsigned lds_dst){unsigned keep;
  asm volatile("s_mov_b32 %0, m0\n\ts_mov_b32 m0, %2\n\ts_nop 0\n\tglobal_load_lds_dwordx4 %1, off\n\ts_mov_b32 m0, %0":"=&s"(keep):"v"(gsrc),"s"(lds_dst):"memory");}
typedef float f32x2_t __attribute__((ext_vector_type(2))); typedef __bf16 bf16x2_t __attribute__((ext_vector_type(2)));
__device__ __forceinline__ unsigned cvtpk_s(float lo,float hi){f32x2_t v={lo,hi};bf16x2_t b=__builtin_convertvector(v,bf16x2_t);return __builtin_bit_cast(unsigned,b);}
#define WAIT_BAR(N) asm volatile("s_waitcnt vmcnt(" #N ") lgkmcnt(0)\n\ts_barrier":::"memory")
#define MFMA32(a,b,c) __builtin_amdgcn_mfma_f32_32x32x16_bf16(a,b,c,0,0,0)
__device__ __forceinline__ unsigned split3(float x,unsigned&h2){
  const unsigned a=cvtpk_s(x,0.f)&0xffffu; const float r1=x-__uint_as_float(a<<16);
  const unsigned b=cvtpk_s(r1,0.f)&0xffffu; const float r2=r1-__uint_as_float(b<<16);
  h2=cvtpk_s(r2,0.f)&0xffffu; return a|(b<<16);
}
typedef short v4i16_t __attribute__((ext_vector_type(4)));
__device__ __forceinline__ void kload8(bf16x8*kf,lds_cptr kp){
  kf[0]=*(const __attribute__((address_space(3))) bf16x8*)(kp);      kf[1]=*(const __attribute__((address_space(3))) bf16x8*)(kp+512);
  kf[2]=*(const __attribute__((address_space(3))) bf16x8*)(kp+2048); kf[3]=*(const __attribute__((address_space(3))) bf16x8*)(kp+2560);
  kf[4]=*(const __attribute__((address_space(3))) bf16x8*)(kp+4096); kf[5]=*(const __attribute__((address_space(3))) bf16x8*)(kp+4608);
  kf[6]=*(const __attribute__((address_space(3))) bf16x8*)(kp+6144); kf[7]=*(const __attribute__((address_space(3))) bf16x8*)(kp+6656);
}
__device__ __forceinline__ void kload2(bf16x8*kf,lds_cptr kp,int j){ kf[2*j]=*(const __attribute__((address_space(3))) bf16x8*)(kp+j*2048); kf[2*j+1]=*(const __attribute__((address_space(3))) bf16x8*)(kp+j*2048+512); }
__device__ __forceinline__ s16x4 vtr(lds_cptr p){ return __builtin_bit_cast(s16x4,__builtin_amdgcn_ds_read_tr16_b64_v4i16((__attribute__((address_space(3))) v4i16_t*)p)); }
__device__ __forceinline__ void pv(f32x16*o,int vb,bf16x8 pa0,bf16x8 pa1,bf16x8 pa2,bf16x8 pa3){
  #pragma unroll
  for(int d0=0;d0<2;++d0){s16x4 lo[4],hi[4];
    #pragma unroll
    for(int ks=0;ks<4;++ks){
      asm volatile("ds_read_b64_tr_b16 %0,%1 offset:%c2":"=&v"(lo[ks]):"v"(vb),"i"(d0*4096+ks*1024):"memory");
      asm volatile("ds_read_b64_tr_b16 %0,%1 offset:%c2":"=&v"(hi[ks]):"v"(vb),"i"(d0*4096+ks*1024+512):"memory");}
    asm volatile("s_waitcnt lgkmcnt(0)":::"memory");SBAR();
    #define PK(k) (bf16x8){lo[k][0],lo[k][1],lo[k][2],lo[k][3],hi[k][0],hi[k][1],hi[k][2],hi[k][3]}
    o[d0]=MFMA32(pa0,PK(0),o[d0]);
    o[d0]=MFMA32(pa1,PK(1),o[d0]);
    o[d0]=MFMA32(pa2,PK(2),o[d0]);
    o[d0]=MFMA32(pa3,PK(3),o[d0]);
    #undef PK
  }
}
__device__ __forceinline__ float wmax(float v){
  v=fmaxf(v,::lx1(v)); v=fmaxf(v,::lx2(v)); v=fmaxf(v,::dppf<0x141>(v)); v=fmaxf(v,::dppf<0x140>(v));
  { auto r=__builtin_amdgcn_permlane16_swap(__float_as_uint(v),__float_as_uint(v),false,false); v=fmaxf(__uint_as_float(r[0]),__uint_as_float(r[1])); }
  { auto r=__builtin_amdgcn_permlane32_swap(__float_as_uint(v),__float_as_uint(v),false,false); v=fmaxf(__uint_as_float(r[0]),__uint_as_float(r[1])); }
  return v;
}

struct Seam { bf16x8 q[4]; float tabv, km0, km1, base, r0, r31, fq; };
template<int MODE> __device__ __forceinline__ int attn_unit(int b,int h,int qb,int T0,const bf16*__restrict__ QKV,const u32x2v*__restrict__ Kaug,const float*__restrict__ Fl2,const float*__restrict__ kmp,
                                                            const float*__restrict__ relb,const float*__restrict__ gtab,const unsigned char*__restrict__ t5b,bf16*__restrict__ O,char*shm,unsigned*ctr,volatile __attribute__((address_space(3))) unsigned*misc,int pre,const int*__restrict__ t0tab,Seam&sm){
  int tid_=threadIdx.x; asm volatile("":"+v"(tid_));
  const int tid=tid_,lane=tid&63,r32=lane&31,hi=lane>>5; const int wid=__builtin_amdgcn_readfirstlane(tid>>6);
  const int bh=b*NHEAD+h; const long rowbase=(long)b*SEQ; const int q0=qb*QB;
  const int cq=(MODE?1536:0)+h*D;
  const bf16*Qw=QKV+(rowbase+q0+wid*QBLK)*QP+cq;
  const bf16*Kh=QKV+rowbase*QP+cq+512,*Vh=QKV+rowbase*QP+cq+1024;
  const unsigned lds0=(unsigned)(uintptr_t)shm;
  float*wsf=(float*)(shm+LDS_WS)+wid*64;
  const bf16*ksrc=Kh+(long)(lane+T0*KVBLK)*QP+wid*8;
  const bf16*vsrc=Vh+(long)(16*(wid&3)+(lane>>2)+T0*KVBLK)*QP+(wid>>2)*32+(lane&3)*8;
  const unsigned kdst=lds0+LDS_K+wid*1024, vdst=lds0+LDS_V+wid*1024;
  #define DMA_K(t,slot) glds16(ksrc+(long)(t)*KVBLK*QP,(unsigned)__builtin_amdgcn_readfirstlane(kdst+(slot)))
  #define DMA_V(t,slot) glds16(vsrc+(long)(t)*KVBLK*QP,(unsigned)__builtin_amdgcn_readfirstlane(vdst+(slot)))
  const int vb0=(int)(lds0+LDS_V)+((lane>>4)&1)*32+(lane&3)*8+(4*hi+((lane&15)>>2))*64;
  const char*Kbase=shm+LDS_K; bf16x8 kf[8];
  const lds_cptr shm3=(lds_cptr)shm; const lds_cptr kp0=shm3+LDS_K+hi*1024+r32*16; const lds_cptr vp0=shm3+LDS_V+((lane>>4)&1)*32+(lane&3)*8+(4*hi+((lane&15)>>2))*64;
  const lds_uptr fau=(lds_uptr)(shm3+LDS_FAUG)+128*T0+r32*2+hi;
  const lds_fptr tabp=(lds_fptr)(shm3+LDS_TAB);
  const int NTA=(q0+QB)/KVBLK, NT=NTA-T0;
  unsigned nxt_=0u; if(tid==0)nxt_=__builtin_amdgcn_atomic_inc32(ctr,0xffffffffu,__ATOMIC_RELAXED,"agent");
  if(!pre){DMA_K(0,0);} DMA_V(0,0); if(!pre){DMA_K(1,SLOTB);}
  bf16x8 qr[4];
  if(pre){
    #pragma unroll
    for(int d0=0;d0<4;++d0)qr[d0]=sm.q[d0];
  }else{
    #pragma unroll
    for(int d0=0;d0<4;++d0)qr[d0]=__builtin_nontemporal_load(reinterpret_cast<const bf16x8*>(&Qw[(long)r32*QP+d0*16+hi*8]));
    asm volatile("":"+v"(qr[0]),"+v"(qr[1]),"+v"(qr[2]),"+v"(qr[3]));
  }
  if(MODE==0){
    if(!pre){ const char*src=(const char*)(Kaug+(size_t)bh*SEQ+KVBLK*T0)+lane*16;
      for(int pc=wid;pc<NT/2;pc+=NW)glds16(src+pc*1024,(unsigned)__builtin_amdgcn_readfirstlane(lds0+LDS_FAUG+KVBLK*T0*8+pc*1024)); }
  }else{
    float tv=0.f,k0v,k1v;
    if(pre){ tv=sm.tabv; k0v=sm.km0; k1v=sm.km1; }
    else { if(tid<113)tv=(relb[t5b[tid]*8+h]-relb[31*8+h])*1.4426950408889634f;
      const float*p0=kmp+((size_t)((bh*16+(tid>>6))*2))*64+(tid&63); const float*p1=kmp+((size_t)((bh*16+8+(tid>>6))*2))*64+(tid&63); k0v=p0[0]+p0[64]; k1v=p1[0]+p1[64]; asm volatile("":"+v"(tv),"+v"(k0v),"+v"(k1v)); }
    float*tb=(float*)(shm+LDS_TAB); if(tid<384)tb[tid]=tv;
    float*kmw=(float*)(shm+LDS_KM); kmw[tid]=k0v; kmw[tid+512]=k1v;
  }
  float Bnd,basev;
  if(pre){ basev=sm.base; Bnd=basev;
    if(MODE==1){ const float bv=lane<32?(sm.r0-sm.r31)*1.4426950408889634f:0.f; Bnd+=fmaxf(wmax(bv),0.f); } }
  else { const float gq=fabsf(gtab[(MODE?128:0)+lane]),gk=fabsf(gtab[(MODE?192:64)+lane]);
    basev=64.f*wmax(gq)*wmax(gk)*(0.125f*1.4426950408889634f)*1.02f+0.25f; Bnd=basev;
    if(MODE==1){ const float bv=lane<32?(relb[lane*8+h]-relb[31*8+h])*1.4426950408889634f:0.f; Bnd+=fmaxf(wmax(bv),0.f); } asm volatile("":"+v"(Bnd),"+v"(basev)); }
  basev=__uint_as_float(__builtin_amdgcn_readfirstlane(__float_as_uint(basev)));
  float fq_row=0.f; if(MODE==0){ if(pre)fq_row=sm.fq; else { fq_row=Fl2[(size_t)bh*SEQ+q0+wid*QBLK+r32]; asm volatile("":"+v"(fq_row)); } }
  float l_reg=0.f;f32x16 o[2];o[0]=f32x16{};o[1]=f32x16{};
  const int qrel=wid*QBLK+r32;
  #define BANDMASK(P0,P1,t) do{int jb_=(t)-(NT-4); if(MODE==1&&jb_>=-2)bias_add(P0,P1,jb_,qrel,hi,tabp); if(jb_>=0)cmask(P0,P1,jb_,qrel,hi);}while(0)
  f32x16 pA0,pA1,pB0,pB1;
  int sl_prev=0,sl_cur=0,sl_next=SLOTB;
  #define ROT() do{sl_prev=sl_cur;sl_cur=sl_next;sl_next=(sl_next==(NSLOT-1)*SLOTB)?0:sl_next+SLOTB;}while(0)
  if(!pre){DMA_K(2,2*SLOTB);}
  WAIT_BAR(3);
  unsigned smask=1u<<qb;
  if(MODE==1&&qb>0){
    f32x16 g=f32x16{};
    const lds_fptr kmr=(lds_fptr)(shm3+LDS_KM)+(r32&15)*64+8*hi;
    #pragma unroll
    for(int d0=0;d0<4;++d0){
      const f32x4v x0=*(const __attribute__((address_space(3))) f32x4v*)(kmr+16*d0),x1=*(const __attribute__((address_space(3))) f32x4v*)(kmr+16*d0+4);
      u32x4 ah,al;
      ah[0]=cvtpk_s(x0[0],x0[1]);ah[1]=cvtpk_s(x0[2],x0[3]);ah[2]=cvtpk_s(x1[0],x1[1]);ah[3]=cvtpk_s(x1[2],x1[3]);
      al[0]=cvtpk_s(x0[0]-__uint_as_float(ah[0]<<16),x0[1]-__uint_as_float(ah[0]&0xffff0000u));
      al[1]=cvtpk_s(x0[2]-__uint_as_float(ah[1]<<16),x0[3]-__uint_as_float(ah[1]&0xffff0000u));
      al[2]=cvtpk_s(x1[0]-__uint_as_float(ah[2]<<16),x1[1]-__uint_as_float(ah[2]&0xffff0000u));
      al[3]=cvtpk_s(x1[2]-__uint_as_float(ah[3]<<16),x1[3]-__uint_as_float(ah[3]&0xffff0000u));
      g=MFMA32(__builtin_bit_cast(bf16x8,ah),qr[d0],g); g=MFMA32(__builtin_bit_cast(bf16x8,al),qr[d0],g);
    }
    float gv[16];
    #pragma unroll
    for(int r=0;r<8;++r){ const float mine=g[r]; auto sw=__builtin_amdgcn_permlane32_swap(__float_as_uint(mine),__float_as_uint(mine),false,false); const float oth=__uint_as_float(hi?sw[0]:sw[1]); const int n0=(r&3)+8*(r>>2); gv[n0]=hi?oth:mine; gv[n0+4]=hi?mine:oth; }
    #pragma unroll
    for(int pick=0;pick<3;++pick){ float best=-3.0e38f; int bi=-1;
      #pragma unroll
      for(int n=0;n<16;++n){ const bool ok=(n<qb)&&!((smask>>n)&1u); if(ok&&gv[n]>best){best=gv[n];bi=n;} }
      if(bi>=0)smask|=1u<<bi; }
  }
  u32x4 qaug=(u32x4){0u,0u,0u,0u}; u32x4 ka0=(u32x4){0u,0u,0u,0u},ka1=(u32x4){0u,0u,0u,0u};
  if(MODE==0){ unsigned h2; const unsigned h01=split3(fq_row-Bnd,h2); qaug[0]=hi?(0x3F80u|(h2<<16)):0x3F803F80u; qaug[1]=hi?0u:h01; ka0[1]=hi?0u:0x3F803F80u; ka1[1]=ka0[1]; ka0[0]=fau[0]; ka1[0]=fau[64]; }
  f32x16 cini=f32x16{};
  #define QAUG_MOBA(nb) do{ const float pen_=((smask>>(nb))&1u)?0.f:256.f; const float cv_=-(Bnd+pen_); _Pragma("unroll") for(int r_=0;r_<16;++r_)cini[r_]=cv_; asm volatile("":"+v"(cini)); }while(0)
  if(MODE==1)QAUG_MOBA(0);
  #define KA(x) __builtin_bit_cast(bf16x8,x)
  { const char*kb=Kbase+hi*1024+r32*16;
    if(MODE==0){ pA0=MFMA32(KA(ka0),KA(qaug),f32x16{}); pA1=MFMA32(KA(ka1),KA(qaug),f32x16{}); } else { pA0=cini; pA1=cini; }
    #pragma unroll
    for(int d0=0;d0<4;++d0){ const bf16x8 b0=*reinterpret_cast<const bf16x8*>(kb+d0*2048); const bf16x8 b1=*reinterpret_cast<const bf16x8*>(kb+d0*2048+512);
      pA0=MFMA32(b0,qr[d0],pA0); pA1=MFMA32(b1,qr[d0],pA1); } }
  BANDMASK(pA0,pA1,0);
  _Pragma("unroll") for(int r=0;r<16;++r){pA0[r]=__builtin_amdgcn_exp2f(pA0[r]);pA1[r]=__builtin_amdgcn_exp2f(pA1[r]);}
  WAIT_BAR(0);
  if(tid==0)misc[2]=nxt_;
  DMA_K(3,0);DMA_V(1,SLOTB);
  ROT();
  kload8(kf,kp0+sl_cur);
  if(MODE==0){ ka0[0]=fau[128]; ka1[0]=fau[128+64]; }
  WAIT_BAR(2);
  s16x4 vlo[8],vhi[8]; u32x4 pw0,pw1,pw2,pw3;
  #define PKW(P,B) cvtpk_s(P[B],P[B+1])
  #define PAF(k) __builtin_bit_cast(bf16x8,pw##k)
  #define VFR(i) (bf16x8){vlo[i][0],vlo[i][1],vlo[i][2],vlo[i][3],vhi[i][0],vhi[i][1],vhi[i][2],vhi[i][3]}
  #define PIN(x) asm volatile("":"+v"(x))
  #define GAPA(MF,A0,A1,A2,A3,W0,W1,PW) do{ MF; sacc+=A0; sacc+=A1; sacc+=A2; sacc+=A3; PIN(sacc); W0; W1; PIN(PW); SBAR(); }while(0)
  #define GAP0(MF) do{ MF; SBAR(); }while(0)
  #define EX(v) __builtin_amdgcn_exp2f(v)
  #define GAPB(MF,X,B) do{ MF; X[B]=EX(X[B]); X[B+1]=EX(X[B+1]); X[B+2]=EX(X[B+2]); X[B+3]=EX(X[B+3]); PIN(X); SBAR(); }while(0)
  #define VRD(i) do{ vlo[i]=vtr(vp_+(((i)>>2)*4096+((i)&3)*1024)); vhi[i]=vtr(vp_+(((i)>>2)*4096+((i)&3)*1024+512)); }while(0)
  #define KRD(G,j) do{ if(G){ kload2(kf,kp0+sl_next,j); SBAR(); } }while(0)
  #define KARD(G,t) do{ if(MODE==0&&(G)){ ka0[0]=fau[128*((t)+1)]; ka1[0]=fau[128*((t)+1)+64]; SBAR(); } }while(0)
  #define STEP(C0,C1,P0,P1,t,GK,GV,GL) do{ SBAR(); \
    const lds_cptr vp_=vp0+sl_prev; \
    if(GK){DMA_K((t)+3,sl_cur);} if(GV){DMA_V((t)+1,sl_next);} SBAR(); \
    if(MODE==1&&(((t)&3)==0)){ QAUG_MOBA((t)>>2); SBAR(); } \
    VRD(0); SBAR(); float sacc=(P0[0]+P0[1]); \
    if(MODE==0){ \
    GAPA(C0=MFMA32(KA(ka0),KA(qaug),f32x16{}), P0[2],P0[3],P0[4],P0[5],     pw0[0]=PKW(P0,0), pw0[1]=PKW(P0,2), pw0); \
    VRD(4); SBAR(); GAPA(C1=MFMA32(KA(ka1),KA(qaug),f32x16{}), P0[6],P0[7],P0[8],P0[9],     pw0[2]=PKW(P0,4), pw0[3]=PKW(P0,6), pw0); \
    VRD(1); SBAR(); GAPA(C0=MFMA32(kf[0],qr[0],C0),   P0[10],P0[11],P0[12],P0[13], pw1[0]=PKW(P0,8), pw1[1]=PKW(P0,10), pw1); \
    VRD(5); SBAR(); GAPA(C1=MFMA32(kf[1],qr[0],C1),   P0[14],P0[15],P1[0],P1[1],   pw1[2]=PKW(P0,12),pw1[3]=PKW(P0,14), pw1); \
    GAPA(C0=MFMA32(kf[2],qr[1],C0),   P1[2],P1[3],P1[4],P1[5],     pw2[0]=PKW(P1,0), pw2[1]=PKW(P1,2), pw2); \
    GAPA(C1=MFMA32(kf[3],qr[1],C1),   P1[6],P1[7],P1[8],P1[9],     pw2[2]=PKW(P1,4), pw2[3]=PKW(P1,6), pw2); \
    GAPA(C0=MFMA32(kf[4],qr[2],C0),   P1[10],P1[11],P1[12],P1[13], pw3[0]=PKW(P1,8), pw3[1]=PKW(P1,10), pw3); \
    GAPA(C1=MFMA32(kf[5],qr[2],C1),   P1[14],P1[15],0.f,0.f,       pw3[2]=PKW(P1,12),pw3[3]=PKW(P1,14), pw3); \
    GAP0(C0=MFMA32(kf[6],qr[3],C0)); GAP0(C1=MFMA32(kf[7],qr[3],C1)); \
    } else { \
    GAPA(C0=MFMA32(kf[0],qr[0],cini), P0[2],P0[3],P0[4],P0[5],     pw0[0]=PKW(P0,0), pw0[1]=PKW(P0,2), pw0); \
    VRD(4); SBAR(); GAPA(C1=MFMA32(kf[1],qr[0],cini), P0[6],P0[7],P0[8],P0[9],     pw0[2]=PKW(P0,4), pw0[3]=PKW(P0,6), pw0); \
    VRD(1); SBAR(); GAPA(C0=MFMA32(kf[2],qr[1],C0),   P0[10],P0[11],P0[12],P0[13], pw1[0]=PKW(P0,8), pw1[1]=PKW(P0,10), pw1); \
    VRD(5); SBAR(); GAPA(C1=MFMA32(kf[3],qr[1],C1),   P0[14],P0[15],P1[0],P1[1],   pw1[2]=PKW(P0,12),pw1[3]=PKW(P0,14), pw1); \
    GAPA(C0=MFMA32(kf[4],qr[2],C0),   P1[2],P1[3],P1[4],P1[5],     pw2[0]=PKW(P1,0), pw2[1]=PKW(P1,2), pw2); \
    GAPA(C1=MFMA32(kf[5],qr[2],C1),   P1[6],P1[7],P1[8],P1[9],     pw2[2]=PKW(P1,4), pw2[3]=PKW(P1,6), pw2); \
    GAPA(C0=MFMA32(kf[6],qr[3],C0),   P1[10],P1[11],P1[12],P1[13], pw3[0]=PKW(P1,8), pw3[1]=PKW(P1,10), pw3); \
    GAPA(C1=MFMA32(kf[7],qr[3],C1),   P1[14],P1[15],0.f,0.f,       pw3[2]=PKW(P1,12),pw3[3]=PKW(P1,14), pw3); \
    } \
    l_reg+=sacc; \
    BANDMASK(C0,C1,t); \
    SBAR(); \
    KARD(GL,t); VRD(2); VRD(6); SBAR(); GAPB(o[0]=MFMA32(PAF(0),VFR(0),o[0]), C0,0); \
    VRD(3); VRD(7); SBAR(); GAPB(o[1]=MFMA32(PAF(0),VFR(4),o[1]), C0,4); \
    KRD(GL,0); GAPB(o[0]=MFMA32(PAF(1),VFR(1),o[0]), C0,8); \
    KRD(GL,1); GAPB(o[1]=MFMA32(PAF(1),VFR(5),o[1]), C0,12); \
    KRD(GL,2); GAPB(o[0]=MFMA32(PAF(2),VFR(2),o[0]), C1,0); \
    KRD(GL,3); GAPB(o[1]=MFMA32(PAF(2),VFR(6),o[1]), C1,4); \
    GAPB(o[0]=MFMA32(PAF(3),VFR(3),o[0]), C1,8); \
    GAPB(o[1]=MFMA32(PAF(3),VFR(7),o[1]), C1,12); \
    }while(0)
  int t=1;
  #undef BANDMASK
  #define BANDMASK(P0,P1,t) do{}while(0)
  for(;t+7<NT;t+=2){
    STEP(pB0,pB1,pA0,pA1,t,true,true,true);     WAIT_BAR(2); ROT();
    STEP(pA0,pA1,pB0,pB1,t+1,true,true,true);   WAIT_BAR(2); ROT();
  }
  #undef BANDMASK
  #define BANDMASK(P0,P1,t) do{int jb_=(t)-(NT-4); if(MODE==1&&jb_>=-2)bias_add(P0,P1,jb_,qrel,hi,tabp); if(jb_>=0)cmask(P0,P1,jb_,qrel,hi);}while(0)
  #define ENDW(tt) do{ if((tt)+3<NT){WAIT_BAR(2);} else if((tt)+2<NT){WAIT_BAR(1);} else {WAIT_BAR(0);} }while(0)
  for(;t+3<NT;t+=2){
    STEP(pB0,pB1,pA0,pA1,t,(t+3<NT),(t+1<NT),(t+1<NT));       ENDW(t);   ROT();
    STEP(pA0,pA1,pB0,pB1,t+1,(t+4<NT),(t+2<NT),(t+2<NT));     ENDW(t+1); ROT();
  }
  #define STEP_PV(P0,P1,t,GK,GV) do{ SBAR(); const lds_cptr vp_=vp0+sl_prev; if(GK){DMA_K((t)+3,sl_cur);} if(GV){DMA_V((t)+1,sl_next);} SBAR(); \
    VRD(0);VRD(4);VRD(1);VRD(5); \
    { float sacc=P0[0]+P0[1]; _Pragma("unroll") for(int r_=2;r_<16;++r_)sacc+=P0[r_]; _Pragma("unroll") for(int r_=0;r_<16;++r_)sacc+=P1[r_]; l_reg+=sacc; } \
    pw0=(u32x4){PKW(P0,0),PKW(P0,2),PKW(P0,4),PKW(P0,6)};pw1=(u32x4){PKW(P0,8),PKW(P0,10),PKW(P0,12),PKW(P0,14)};pw2=(u32x4){PKW(P1,0),PKW(P1,2),PKW(P1,4),PKW(P1,6)};pw3=(u32x4){PKW(P1,8),PKW(P1,10),PKW(P1,12),PKW(P1,14)}; SBAR(); \
    VRD(2);VRD(6);VRD(3);VRD(7); \
    o[0]=MFMA32(PAF(0),VFR(0),o[0]); o[1]=MFMA32(PAF(0),VFR(4),o[1]); o[0]=MFMA32(PAF(1),VFR(1),o[0]); o[1]=MFMA32(PAF(1),VFR(5),o[1]); \
    o[0]=MFMA32(PAF(2),VFR(2),o[0]); o[1]=MFMA32(PAF(2),VFR(6),o[1]); o[0]=MFMA32(PAF(3),VFR(3),o[0]); o[1]=MFMA32(PAF(3),VFR(7),o[1]); SBAR(); }while(0)
  STEP(pB0,pB1,pA0,pA1,t,(t+3<NT),(t+1<NT),(t+1<NT));       ENDW(t);   ROT();
  const int nx_=__builtin_amdgcn_readfirstlane((int)misc[2]); const bool pre_next=nx_<128;
  if(SKIP_MODES(MODE)&&wid<4){
  STEP_PV(pB0,pB1,t+1,false,true); ENDW(t+1); ROT();
  if(pre_next){ const int qb2=15-(nx_>>3),h2=nx_&7; int T2=0; if(MODE==0)T2=__builtin_amdgcn_readfirstlane(((const __attribute__((address_space(3))) int*)(shm3+LDS_TAB))[h2*16+qb2]);
    const bf16*ks2=QKV+(rowbase+(long)(T2*KVBLK+lane))*QP+(MODE?1536:0)+h2*D+512+wid*8;
    glds16(ks2,(unsigned)__builtin_amdgcn_readfirstlane(kdst)); glds16(ks2+(long)KVBLK*QP,(unsigned)__builtin_amdgcn_readfirstlane(kdst+SLOTB)); glds16(ks2+(long)2*KVBLK*QP,(unsigned)__builtin_amdgcn_readfirstlane(kdst+2*SLOTB));
    if(MODE==0){ const int NT2=4*(qb2+1)-T2; const char*src2=(const char*)(Kaug+(size_t)(b*NHEAD+h2)*SEQ+KVBLK*T2)+lane*16;
      for(int pc=wid;pc<NT2/2;pc+=NW)glds16(src2+pc*1024,(unsigned)__builtin_amdgcn_readfirstlane(lds0+LDS_FAUG+KVBLK*T2*8+pc*1024)); } }
  }else{
  STEP(pA0,pA1,pB0,pB1,t+1,false,true,true); ENDW(t+1); ROT();
  if(pre_next){ const int qb2=15-(nx_>>3),h2=nx_&7; int T2=0; if(MODE==0)T2=__builtin_amdgcn_readfirstlane(((const __attribute__((address_space(3))) int*)(shm3+LDS_TAB))[h2*16+qb2]);
    const bf16*ks2=QKV+(rowbase+(long)(T2*KVBLK+lane))*QP+(MODE?1536:0)+h2*D+512+wid*8;
    glds16(ks2,(unsigned)__builtin_amdgcn_readfirstlane(kdst)); glds16(ks2+(long)KVBLK*QP,(unsigned)__builtin_amdgcn_readfirstlane(kdst+SLOTB)); glds16(ks2+(long)2*KVBLK*QP,(unsigned)__builtin_amdgcn_readfirstlane(kdst+2*SLOTB));
    if(MODE==0){ const int NT2=4*(qb2+1)-T2; const char*src2=(const char*)(Kaug+(size_t)(b*NHEAD+h2)*SEQ+KVBLK*T2)+lane*16;
      for(int pc=wid;pc<NT2/2;pc+=NW)glds16(src2+pc*1024,(unsigned)__builtin_amdgcn_readfirstlane(lds0+LDS_FAUG+KVBLK*T2*8+pc*1024)); } }
  STEP(pB0,pB1,pA0,pA1,NT-1,false,false,false);
  { float sacc=pB0[0]+pB0[1]; _Pragma("unroll") for(int r=2;r<16;++r)sacc+=pB0[r]; _Pragma("unroll") for(int r=0;r<16;++r)sacc+=pB1[r]; l_reg+=sacc;
    pw0=(u32x4){PKW(pB0,0),PKW(pB0,2),PKW(pB0,4),PKW(pB0,6)};pw1=(u32x4){PKW(pB0,8),PKW(pB0,10),PKW(pB0,12),PKW(pB0,14)};pw2=(u32x4){PKW(pB1,0),PKW(pB1,2),PKW(pB1,4),PKW(pB1,6)};pw3=(u32x4){PKW(pB1,8),PKW(pB1,10),PKW(pB1,12),PKW(pB1,14)};
    SBAR(); pv(o,vb0+sl_cur,PAF(0),PAF(1),PAF(2),PAF(3)); }
  }
  int tid_t=threadIdx.x; asm volatile("":"+v"(tid_t)); const int lane_t=tid_t&63,r32_t=lane_t&31,hi_t=lane_t>>5;
  int qb2_=0,h2_=0,T2_=0;
  _Pragma("unroll") for(int d0=0;d0<4;++d0)sm.q[d0]=(bf16x8){0,0,0,0,0,0,0,0}; sm.tabv=0.f; sm.km0=0.f; sm.km1=0.f; sm.r0=0.f; sm.r31=0.f; sm.fq=0.f; sm.base=basev;
  if(pre_next){ qb2_=15-(nx_>>3); h2_=nx_&7; if(MODE==0)T2_=__builtin_amdgcn_readfirstlane(((const __attribute__((address_space(3))) int*)(shm3+LDS_TAB))[h2_*16+qb2_]);
    const bf16*Qw2=QKV+(rowbase+(long)(qb2_*QB+wid*QBLK))*QP+(MODE?1536:0)+h2_*D;
    #pragma unroll
    for(int d0=0;d0<4;++d0)sm.q[d0]=__builtin_nontemporal_load(reinterpret_cast<const bf16x8*>(&Qw2[(long)r32_t*QP+d0*16+hi_t*8]));
    if(MODE==0){ sm.fq=Fl2[(size_t)(b*NHEAD+h2_)*SEQ+qb2_*QB+wid*QBLK+r32_t]; }
    else { const int bh2=b*NHEAD+h2_; sm.tabv=0.f; sm.r0=lane_t<32?relb[lane_t*8+h2_]:0.f; sm.r31=relb[31*8+h2_]; if(tid_t<113)sm.tabv=(relb[t5b[tid_t]*8+h2_]-relb[31*8+h2_])*1.4426950408889634f;
      const float*p0=kmp+((size_t)((bh2*16+(tid_t>>6))*2))*64+(tid_t&63); const float*p1=kmp+((size_t)((bh2*16+8+(tid_t>>6))*2))*64+(tid_t&63); sm.km0=p0[0]+p0[64]; sm.km1=p1[0]+p1[64]; } }
  #undef PKW
  #undef PAF
  #undef VFR
  #undef PIN
  #undef GAPA
  #undef GAP0
  #undef GAPB
  #undef EX
  #undef VRD
  #undef KRD
  #undef KARD
  #undef STEP
  #undef STEP_PV
  #undef ENDW
  #undef KA
  #undef QAUG_MOBA
  {auto rr=__builtin_amdgcn_permlane32_swap(__float_as_uint(l_reg),__float_as_uint(l_reg),false,false);l_reg=__uint_as_float(rr[0])+__uint_as_float(rr[1]);}
  if(hi_t==0)wsf[32+r32_t]=l_reg;asm volatile("s_waitcnt lgkmcnt(0)":::"memory");
  float rli[16];
  #pragma unroll
  for(int r=0;r<16;++r)rli[r]=__builtin_amdgcn_rcpf(wsf[32+crow(r,hi_t)]);
  bf16*Ow=O+(rowbase+q0+wid*QBLK)*OP+MODE*512+h*D;
  { bf16*stg=(bf16*)(shm+LDS_OST)+wid*2048;
    #pragma unroll
    for(int r=0;r<16;++r){const int orow=crow(r,hi_t);
      #pragma unroll
      for(int d0=0;d0<2;++d0)stg[orow*64+d0*32+r32_t]=__float2bfloat16(o[d0][r]*rli[r]);}
    asm volatile("s_waitcnt lgkmcnt(0)":::"memory");
    #pragma unroll
    for(int i=0;i<4;++i){const int row=i*8+(lane_t>>3),ch=lane_t&7; const u32x4 v=*(const u32x4*)(stg+row*64+ch*8); *(u32x4*)(Ow+(long)row*OP+ch*8)=v;} }
  if(tid_t==0)misc[0]=nxt_;
  asm volatile("s_waitcnt lgkmcnt(0)\n\ts_barrier":::"memory");
  const int next_unit=(int)misc[0];
  #undef DMA_K
  #undef DMA_V
  #undef BANDMASK
  #undef ROT
  return next_unit;
}
constexpr int ATTN_LDS_BYTES=LDS_BYTES;
#undef SBAR
#undef WAIT_BAR
#undef MFMA32
}

#define LAS __attribute__((address_space(3)))
typedef unsigned short bf16_t;
constexpr int NWAVES = 8, NTHREADS = 512;
constexpr int RING_BYTES = 131072, EXT_OFF = RING_BYTES + 256, LDS_BYTES = 150528;
#define LDS_WAIT() asm volatile("s_waitcnt lgkmcnt(0)" ::: "memory")
#ifndef P0B_W16
#define P0B_W16 1
#endif
#ifdef NT_P0
#define LDW(p) __builtin_nontemporal_load((const float*)(p))
#else
#define LDW(p) (*(const float*)(p))
#endif
#ifdef NT_X
#define LDX(p) __builtin_nontemporal_load((const f32x4*)(p))
#else
#define LDX(p) (*(const f32x4*)(p))
#endif

struct Params { const float* in[17]; float* out; unsigned char* ws; };

#define XB_TMO      128
#define XB_XCNT(j)  (256  + 64 * (j))
#define XB_XSUB(j)  (1280 + 64 * (j))
#define XB_XGEN(j)  (2304 + 64 * (j))
#define XB_TOP      3328
#define XB_TOPGEN   3392
#define XCD_BAR_WORDS 3456
#define XB_SPIN_CAP (1u << 18)

__device__ __forceinline__ unsigned xb_ld(unsigned* p)              { return __hip_atomic_load(p, __ATOMIC_RELAXED, __HIP_MEMORY_SCOPE_AGENT); }
__device__ __forceinline__ unsigned xb_add(unsigned* p, unsigned v) { return __hip_atomic_fetch_add(p, v, __ATOMIC_RELAXED, __HIP_MEMORY_SCOPE_AGENT); }
__device__ __forceinline__ unsigned xb_xcc_id() { return (unsigned)__builtin_amdgcn_s_getreg((3 << 11) | 20) & 0xFu; }
#define XB_SPIN(cond, bar) do { unsigned _sp = 0; while (cond) { __builtin_amdgcn_s_sleep(1); \
    if ((++_sp & 255u) == 0u) { if (xb_ld(&(bar)[XB_TMO])) break; if (_sp > XB_SPIN_CAP) { atomicAdd(&(bar)[XB_TMO], 1u); break; } } } } while (0)

struct XcdBarrier {
    unsigned* bar; unsigned x;
    volatile LAS unsigned* st;
};

__device__ __forceinline__ XcdBarrier xcd_barrier_post(unsigned* bar, volatile LAS unsigned* st) {
    XcdBarrier b; b.bar = bar; b.x = xb_xcc_id(); b.st = st;
    if (threadIdx.x == 0) (void)xb_add(&bar[XB_XCNT(b.x)], 1u);
    return b;
}
__device__ __forceinline__ void xcd_barrier_complete(unsigned* bar, unsigned x, unsigned& nloc, unsigned& nx) {
    const unsigned G = gridDim.x * gridDim.y * gridDim.z;
    unsigned sum, cnt, mine, sp = 0u;
    for (;;) {
        sum = 0u; cnt = 0u; mine = 0u;
#pragma unroll
        for (unsigned j = 0; j < 16; ++j) { const unsigned c = xb_ld(&bar[XB_XCNT(j)]); sum += c; cnt += (c > 0u) ? 1u : 0u; mine = (j == x) ? c : mine; }
        if (sum == G) break;
        __builtin_amdgcn_s_sleep(1);
        if ((++sp & 255u) == 0u) { if (xb_ld(&bar[XB_TMO])) break; if (sp > XB_SPIN_CAP) { atomicAdd(&bar[XB_TMO], 1u); break; } }
    }
    nloc = mine > 0u ? mine : 1u; nx = cnt > 0u ? cnt : 1u;
}

__device__ __forceinline__ void xcd_barrier(const XcdBarrier& b) {
    asm volatile("s_waitcnt vmcnt(0)" ::: "memory");
    __syncthreads();
    if (threadIdx.x == 0) {
        unsigned* bar = b.bar;
        __builtin_amdgcn_s_waitcnt(0);
        unsigned nloc = b.st[0], nx = b.st[1];
        if (nloc == 0u) { xcd_barrier_complete(bar, b.x, nloc, nx); b.st[0] = nloc; b.st[1] = nx; }
        const unsigned old = xb_add(&bar[XB_XSUB(b.x)], 1u);
        const unsigned gen = old / nloc;
        if (old + 1u == (gen + 1u) * nloc) {
            __builtin_amdgcn_fence(__ATOMIC_RELEASE, "agent");
            asm volatile("s_waitcnt vmcnt(0)" ::: "memory");
            const unsigned og = xb_add(&bar[XB_TOP], 1u);
            const unsigned tg = og / nx;
            if (og + 1u == (tg + 1u) * nx) xb_add(&bar[XB_TOPGEN], 1u);
            else XB_SPIN(xb_ld(&bar[XB_TOPGEN]) == tg, bar);
            __builtin_amdgcn_fence(__ATOMIC_ACQUIRE, "agent");
            xb_add(&bar[XB_XGEN(b.x)], 1u);
            asm volatile("s_waitcnt vmcnt(0)" ::: "memory");
        } else {
            XB_SPIN(xb_ld(&bar[XB_XGEN(b.x)]) == gen, bar);
            __builtin_amdgcn_fence(__ATOMIC_ACQUIRE, "agent");
            asm volatile("s_waitcnt vmcnt(0)" ::: "memory");
        }
    }
    __syncthreads();
}


__device__ __forceinline__ void tr_item(const float* __restrict__ W, int Nsrc, int K, int k0, int nsrc0, bf16_t* __restrict__ WT, int nout0, LAS float* scr, int lane) {
    float wv_[32];
#pragma unroll
    for (int i = 0; i < 32; ++i) wv_[i] = LDW(W + (size_t)(k0 + 2 * i + (lane >> 5)) * Nsrc + nsrc0 + (lane & 31));
#pragma unroll
    for (int i = 0; i < 32; ++i) scr[(2 * i + (lane >> 5)) * 33 + (lane & 31)] = wv_[i];
    LDS_WAIT(); asm volatile("" ::: "memory");
    const int c = lane & 7;
#pragma unroll
    for (int j = 0; j < 4; ++j) { const int n = (lane >> 3) + 8 * j; const LAS float* s = scr + (8 * c) * 33 + n;
        u32x4 o; o.x = pk2(s[0 * 33], s[1 * 33]); o.y = pk2(s[2 * 33], s[3 * 33]); o.z = pk2(s[4 * 33], s[5 * 33]); o.w = pk2(s[6 * 33], s[7 * 33]);
        *(u32x4*)(WT + (size_t)(nout0 + n) * K + k0 + 8 * c) = o; }
    LDS_WAIT(); asm volatile("" ::: "memory");
}
__device__ __forceinline__ void p0_weights(const Params& p, LAS unsigned char* lds, int gw, int ngw, int wave, int lane) {
    LAS float* scr = (LAS float*)(lds + wave * 16384);
    bf16_t* Wt_in = (bf16_t*)(p.ws + WS_WIN); bf16_t* Wt_o = (bf16_t*)(p.ws + WS_WO); bf16_t* Wt_gu = (bf16_t*)(p.ws + WS_WGU); bf16_t* Wt_dn = (bf16_t*)(p.ws + WS_WDN);
    constexpr int I_IN = 16 * 96, I_O = 16 * 32, I_GU = 16 * 176, I_DN = 44 * 32, NIT = I_IN + I_O + I_GU + I_DN;
    for (int it = gw; it < NIT; it += ngw) {
        int r = it;
        if (r < I_IN) { const int kb = r / 96, nb = r % 96, L0 = 32 * nb, pn = L0 >> 8, bj = (L0 >> 7) & 1, wc = (L0 >> 5) & 3, sec = pn >> 1, head = 4 * (pn & 1) + wc;
            const int src = 512 * sec + (sec >= 3 ? 8 : 0) + 64 * head + 32 * bj;
            tr_item(p.in[6], INC, DM, 64 * kb, src, Wt_in, L0, scr, lane); continue; }
        r -= I_IN;
        if (r < I_O) { const int kb = r / 32, nb = r % 32; tr_item(p.in[13], DM, DM, 64 * kb, 32 * nb, Wt_o, 32 * nb, scr, lane); continue; }
        r -= I_O;
        if (r < I_GU) { const int kb = r / 176, nb = r % 176, L0 = 32 * nb, pn = L0 >> 8, bj = (L0 >> 7) & 1, j0 = L0 & 127;
            tr_item(bj ? p.in[15] : p.in[14], DFF, DM, 64 * kb, 128 * pn + j0, Wt_gu, L0, scr, lane); continue; }
        r -= I_GU;
        { const int kb = r / 32, nb = r % 32; tr_item(p.in[16], DM, DFF, 64 * kb, 32 * nb, Wt_dn, 32 * nb, scr, lane); }
    }
}
__device__ __forceinline__ void p0_mod(const Params& p, LAS unsigned char* lds, int tid, int wave, int lane) {
    LAS float* sc = (LAS float*)lds; LAS float* red = (LAS float*)(lds + 32768);
    const float* c = p.in[1]; const float* w_ada = p.in[2]; const float* b_ada = p.in[3]; float* mod = (float*)(p.ws + WS_MOD);
    for (int i = tid; i < 8192; i += NTHREADS) { const float v = c[i]; sc[i] = v / (1.f + expf(-v)); }
    __syncthreads();
    const int col = blockIdx.x * 64 + lane;
    float a0 = 0, a1 = 0, a2 = 0, a3 = 0, a4 = 0, a5 = 0, a6 = 0, a7 = 0;
#pragma unroll 1
    for (int kb = wave * 128; kb < wave * 128 + 128; kb += 16) {
        float wv_[16];
#pragma unroll
        for (int i = 0; i < 16; ++i) wv_[i] = LDW(w_ada + (size_t)(kb + i) * 6144 + col);
#pragma unroll
        for (int i = 0; i < 16; ++i) { const float w = wv_[i]; const int k = kb + i;
            a0 += sc[k] * w; a1 += sc[1024 + k] * w; a2 += sc[2048 + k] * w; a3 += sc[3072 + k] * w;
            a4 += sc[4096 + k] * w; a5 += sc[5120 + k] * w; a6 += sc[6144 + k] * w; a7 += sc[7168 + k] * w;
            if ((i & 3) == 3) asm volatile("" ::: "memory"); }
    }
    LAS float* rw = red + wave * 512 + lane;
    rw[0] = a0; rw[64] = a1; rw[128] = a2; rw[192] = a3; rw[256] = a4; rw[320] = a5; rw[384] = a6; rw[448] = a7;
    __syncthreads();
    { const int b = tid >> 6; float s = 0.f;
#pragma unroll
      for (int w = 0; w < 8; ++w) s += red[w * 512 + b * 64 + lane];
      mod[b * 6144 + col] = s + b_ada[col]; }
    __syncthreads();
}
__device__ __forceinline__ float red8(const float (&ff)[8], int lane) {
    const bool b0 = (lane & 1) != 0, b1 = (lane & 2) != 0, b2 = (lane & 4) != 0;
    float t[4], u[2];
#pragma unroll
    for (int k = 0; k < 4; ++k) { const float a = b0 ? ff[2 * k + 1] : ff[2 * k], o = b0 ? ff[2 * k] : ff[2 * k + 1]; t[k] = a + lx1(o); }
#pragma unroll
    for (int k = 0; k < 2; ++k) { const float a = b1 ? t[2 * k + 1] : t[2 * k], o = b1 ? t[2 * k] : t[2 * k + 1]; u[k] = a + lx2(o); }
    float w = (b2 ? u[1] : u[0]) + lx4(b2 ? u[0] : u[1], b2);
    w += lx8(w); w = addx16(w); w = addx32(w);
    return w;
}
#if P0B_W16
#define KIDX(j) (512 * ((j) >> 1) + 8 * lane + 4 * ((j) & 1))
#else
#define KIDX(j) (256 * (j) + 4 * lane)
#endif
__device__ __forceinline__ void p0b_rows(const Params& p, LAS unsigned char* lds, int tid, int gw, int ngw, int lane) {
    const float* x = p.in[0]; const float* mod = (const float*)(p.ws + WS_MOD); const float* gain = p.in[4]; const float* w_in = p.in[6]; const float* b_forget = p.in[7];
    bf16_t* XN = (bf16_t*)(p.ws + WS_XN); float* logf = (float*)(p.ws + WS_LOGF);
    LAS float* wf = (LAS float*)lds;
    for (int i = tid; i < 8192; i += NTHREADS) { const int k = i >> 3, h = i & 7; wf[h * 1024 + k] = w_in[(size_t)k * INC + 1536 + h]; }
    __syncthreads();
    const float bfv = b_forget[lane & 7];
    const int RPW = MROWS / ngw;
#pragma unroll 1
    for (int rbase = gw * RPW; rbase < MROWS; rbase += ngw * RPW) {
        const int b = rbase >> 12;
        const float* shift = mod + b * 6144; const float* scale = shift + 1024;
        f32x4 gs[4], sh[4];
#pragma unroll
        for (int j = 0; j < 4; ++j) { const int k = KIDX(j); gs[j] = *(const f32x4*)(gain + k) * (*(const f32x4*)(scale + k) + 1.0f); sh[j] = *(const f32x4*)(shift + k); }
        asm volatile("" ::: "memory");
        f32x4 c0[4], c1[4], n0[4], n1[4];
#pragma unroll
        for (int j = 0; j < 4; ++j) { c0[j] = LDX(x + (size_t)rbase * DM + KIDX(j)); c1[j] = LDX(x + (size_t)(rbase + 1) * DM + KIDX(j)); }
#pragma unroll 1
        for (int i = 0; i < RPW; i += 2) {
            const int r0 = rbase + i, r1 = r0 + 1;
            if (i + 2 < RPW) {
#pragma unroll
                for (int j = 0; j < 4; ++j) { n0[j] = LDX(x + (size_t)(r0 + 2) * DM + KIDX(j)); n1[j] = LDX(x + (size_t)(r0 + 3) * DM + KIDX(j)); }
            }
            typedef float f32x2s_ __attribute__((ext_vector_type(2)));
            f32x2s_ q0a = {0.f, 0.f}, q0b = {0.f, 0.f}, q1a = {0.f, 0.f}, q1b = {0.f, 0.f};
#pragma unroll
            for (int j = 0; j < 4; ++j) { const f32x2s_ a0 = {c0[j][0], c0[j][1]}, b0 = {c0[j][2], c0[j][3]}, a1 = {c1[j][0], c1[j][1]}, b1 = {c1[j][2], c1[j][3]};
                q0a = __builtin_elementwise_fma(a0, a0, q0a); q0b = __builtin_elementwise_fma(b0, b0, q0b); q1a = __builtin_elementwise_fma(a1, a1, q1a); q1b = __builtin_elementwise_fma(b1, b1, q1b); }
            float s0 = (q0a.x + q0a.y) + (q0b.x + q0b.y), s1 = (q1a.x + q1a.y) + (q1b.x + q1b.y);
            s0 = wave_sum(s0); s1 = wave_sum(s1);
            const float rs0 = __builtin_amdgcn_rsqf(s0 * (1.0f / DM) + EPS), rs1 = __builtin_amdgcn_rsqf(s1 * (1.0f / DM) + EPS);
            typedef float f32x2_ __attribute__((ext_vector_type(2)));
            f32x2_ g0[8], g1[8]; u32x2 wp0 = {0u, 0u}, wp1 = {0u, 0u};
#pragma unroll
            for (int hh = 0; hh < 8; ++hh) { g0[hh] = (f32x2_){0.f, 0.f}; g1[hh] = (f32x2_){0.f, 0.f}; }
#pragma unroll
            for (int j = 0; j < 4; ++j) {
                const int k = KIDX(j);
                const f32x4 h0 = (c0[j] * rs0) * gs[j] + sh[j], h1 = (c1[j] * rs1) * gs[j] + sh[j];
                u32x2 w0, w1; w0.x = pg8::cvt_pk_bf16(h0[0], h0[1]); w0.y = pg8::cvt_pk_bf16(h0[2], h0[3]); w1.x = pg8::cvt_pk_bf16(h1[0], h1[1]); w1.y = pg8::cvt_pk_bf16(h1[2], h1[3]);
#if P0B_W16
                if (j & 1) { u32x4 q0, q1; q0.x = wp0.x; q0.y = wp0.y; q0.z = w0.x; q0.w = w0.y; q1.x = wp1.x; q1.y = wp1.y; q1.z = w1.x; q1.w = w1.y;
                    *(u32x4*)(XN + (size_t)r0 * DM + k - 4) = q0; *(u32x4*)(XN + (size_t)r1 * DM + k - 4) = q1; }
                else { wp0 = w0; wp1 = w1; }
#else
                *(u32x2*)(XN + (size_t)r0 * DM + k) = w0; *(u32x2*)(XN + (size_t)r1 * DM + k) = w1;
#endif
                f32x4 wv[8];
#pragma unroll
                for (int hh = 0; hh < 8; ++hh) wv[hh] = *(const LAS f32x4*)(wf + hh * 1024 + k);
                asm volatile("" ::: "memory");
#pragma unroll
                for (int hh = 0; hh < 8; ++hh) { const f32x2_ wa = {wv[hh][0], wv[hh][1]}, wb = {wv[hh][2], wv[hh][3]};
                    g0[hh] = __builtin_elementwise_fma((f32x2_){h0[0], h0[1]}, wa, g0[hh]); g1[hh] = __builtin_elementwise_fma((f32x2_){h1[0], h1[1]}, wa, g1[hh]);
                    g0[hh] = __builtin_elementwise_fma((f32x2_){h0[2], h0[3]}, wb, g0[hh]); g1[hh] = __builtin_elementwise_fma((f32x2_){h1[2], h1[3]}, wb, g1[hh]); }
            }
            float f0[8], f1[8];
#pragma unroll
            for (int hh = 0; hh < 8; ++hh) { f0[hh] = g0[hh].x + g0[hh].y; f1[hh] = g1[hh].x + g1[hh].y; }
            const float z0 = red8(f0, lane) + bfv, z1 = red8(f1, lane) + bfv;
            if (lane < 8) {
                float* lf = logf + ((size_t)(b * 8 + lane)) * SEQ + (r0 & 4095);
                lf[0] = fminf(z0, 0.f) - log1pf(expf(-fabsf(z0)));
                lf[1] = fminf(z1, 0.f) - log1pf(expf(-fabsf(z1)));
            }
#pragma unroll
            for (int j = 0; j < 4; ++j) { c0[j] = n0[j]; c1[j] = n1[j]; }
        }
    }
}
#undef KIDX
__device__ __forceinline__ void p0b_c2(const Params& p, LAS unsigned char* lds, int tid, int gw, int ngw, int lane) {
    const float* mod = (const float*)(p.ws + WS_MOD); const bf16_t* Wgu = (const bf16_t*)(p.ws + WS_WGU); float* c2 = (float*)(p.ws + WS_C2);
    LAS float* s2 = (LAS float*)(lds + 32768);
    for (int i = tid; i < 8192; i += NTHREADS) s2[i] = mod[(i >> 10) * 6144 + 3 * 1024 + (i & 1023)];
    __syncthreads();
#pragma unroll 1
    for (int n = gw; n < NGU; n += ngw) {
        const u32x4 w0 = *(const u32x4*)(Wgu + (size_t)n * DM + 16 * lane), w1 = *(const u32x4*)(Wgu + (size_t)n * DM + 16 * lane + 8);
        const float wv[16] = {bf2f(w0.x & 0xffffu), bf2f(w0.x >> 16), bf2f(w0.y & 0xffffu), bf2f(w0.y >> 16), bf2f(w0.z & 0xffffu), bf2f(w0.z >> 16), bf2f(w0.w & 0xffffu), bf2f(w0.w >> 16),
                              bf2f(w1.x & 0xffffu), bf2f(w1.x >> 16), bf2f(w1.y & 0xffffu), bf2f(w1.y >> 16), bf2f(w1.z & 0xffffu), bf2f(w1.z >> 16), bf2f(w1.w & 0xffffu), bf2f(w1.w >> 16)};
        float a[8];
#pragma unroll
        for (int b = 0; b < 8; ++b) {
            const LAS float* sh = s2 + b * 1024 + 16 * lane; float t = 0.f;
#pragma unroll
            for (int q4 = 0; q4 < 4; ++q4) { const f32x4 s4 = *(const LAS f32x4*)(sh + 4 * q4); t += (s4[0] * wv[4 * q4] + s4[1] * wv[4 * q4 + 1]) + (s4[2] * wv[4 * q4 + 2] + s4[3] * wv[4 * q4 + 3]); }
            a[b] = t;
        }
        const float r = red8(a, lane);
        if (lane < 8) c2[lane * NGU + n] = r;
    }
}
#ifndef FOX_SKIP_BITS
#define FOX_SKIP_BITS 40
#endif
__device__ __forceinline__ void p1_scan(const Params& p, LAS unsigned char* lds, int tid) {
    LAS double* part = (LAS double*)lds;
    const float* src = (const float*)(p.ws + WS_LOGF) + (size_t)blockIdx.x * SEQ + tid * 8;
    double run = 0.0; double loc[8];
#pragma unroll
    for (int i = 0; i < 8; ++i) { run += (double)src[i]; loc[i] = run; }
    double inc = run;
#pragma unroll
    for (int o = 1; o < 64; o <<= 1) { const double up = __shfl_up(inc, o); if ((tid & 63) >= o) inc += up; }
    if ((tid & 63) == 63) part[tid >> 6] = inc;
    __syncthreads();
    double off = inc - run;
    for (int w = 0; w < (tid >> 6); ++w) off += part[w];
    float* dst = (float*)(p.ws + WS_FL2) + (size_t)blockIdx.x * SEQ + tid * 8;
    u32x2* ka = (u32x2*)(p.ws + WS_KAUG) + (size_t)blockIdx.x * SEQ + tid * 8;
#pragma unroll
    for (int i = 0; i < 8; ++i) {
        const double v = -(off + loc[i]) * 1.4426950408889634;
        dst[i] = (float)(-v);
        const unsigned h0 = f2bf((float)v); const double r1 = v - (double)bf2f(h0);
        const unsigned h1 = f2bf((float)r1); const double r2 = r1 - (double)bf2f(h1);
        const unsigned h2 = f2bf((float)r2);
        u32x2 w; w.x = h0 | (h1 << 16); w.y = h2 | 0x3F800000u; ka[i] = w;
    }
    float thr = 152.0f;
    if (tid < 64) { const float* gt = (const float*)(p.ws + WS_GT); const float gq = fabsf(gt[tid]), gk = fabsf(gt[64 + tid]);
        const float Bq = 64.f * attn_body::wmax(gq) * attn_body::wmax(gk) * (0.125f * 1.4426950408889634f) * 1.02f + 0.25f; thr = fminf(152.0f, 2.0f * Bq + (float)FOX_SKIP_BITS); }
    __syncthreads();
    LAS float* tend = (LAS float*)(lds + 8192); LAS float* fq0 = tend + 64;
    if ((tid & 7) == 7) tend[tid >> 3] = (float)((off + loc[7]) * 1.4426950408889634);
    if ((tid & 31) == 0) fq0[tid >> 5] = (float)((off + loc[0]) * 1.4426950408889634);
    __syncthreads();
    if (tid < 16) { int cnt = 0; const float f0 = fq0[tid]; for (int t = 0; t < 4 * tid; ++t) cnt += (tend[t] - f0 > thr) ? 1 : 0; ((int*)(p.ws + WS_T0))[blockIdx.x * 16 + tid] = cnt & ~1; }
    __syncthreads();
}

#ifndef REP_P0
#define REP_P0 1
#endif
#ifndef REP_P0B
#define REP_P0B 1
#endif
#ifndef REP_P1
#define REP_P1 1
#endif
#ifndef REP_P2
#define REP_P2 1
#endif
#ifndef REP_P3
#define REP_P3 1
#endif
#ifndef REP_P4
#define REP_P4 1
#endif
constexpr int CTL_MODCNT = 3584, CTL_SCANCNT = 3648;
__device__ __forceinline__ void flag_arrive(unsigned* cnt) {
    asm volatile("s_waitcnt vmcnt(0)" ::: "memory");
    __syncthreads();
    if (threadIdx.x == 0) { __builtin_amdgcn_fence(__ATOMIC_RELEASE, "agent"); asm volatile("s_waitcnt vmcnt(0)" ::: "memory"); (void)xb_add(cnt, 1u); }
}
__device__ __forceinline__ void flag_wait(unsigned* cnt, unsigned need, unsigned* bar) {
    if (threadIdx.x == 0) { XB_SPIN(xb_ld(cnt) < need, bar); __builtin_amdgcn_fence(__ATOMIC_ACQUIRE, "agent"); asm volatile("s_waitcnt vmcnt(0)" ::: "memory"); }
    __syncthreads();
}
__global__ void __launch_bounds__(NTHREADS, 2) mega_fwd(Params p) {
    extern __shared__ __attribute__((aligned(16))) unsigned char lds[];
    LAS unsigned char* L = (LAS unsigned char*)lds;
    const int tid = threadIdx.x, lane = tid & 63, wave = __builtin_amdgcn_readfirstlane(tid >> 6);
    const int G = gridDim.x, gw = blockIdx.x * NWAVES + wave, ngw = G * NWAVES;
    unsigned char* ws = p.ws;
    volatile LAS unsigned* MISC = (volatile LAS unsigned*)(L + RING_BYTES);
    if (tid < 16) MISC[tid] = 0u;
    __syncthreads();
    XcdBarrier xbar = xcd_barrier_post((unsigned*)(ws + WS_CTL), MISC + 8);
#define GRID_BAR() xcd_barrier(xbar)
    const bf16_t* Wt_in = (const bf16_t*)(ws + WS_WIN); const bf16_t* Wt_o = (const bf16_t*)(ws + WS_WO); const bf16_t* Wt_gu = (const bf16_t*)(ws + WS_WGU); const bf16_t* Wt_dn = (const bf16_t*)(ws + WS_WDN);
    bf16_t* XN = (bf16_t*)(ws + WS_XN); bf16_t* QKV = (bf16_t*)(ws + WS_QKV); bf16_t* Hb = (bf16_t*)(ws + WS_H); bf16_t* ATT = (bf16_t*)(ws + WS_ATT);
    float* mod = (float*)(ws + WS_MOD); float* c2 = (float*)(ws + WS_C2); float* kmp = (float*)(ws + WS_KMP); float* rsq = (float*)(ws + WS_RSQ);

#ifdef EXTRA_SYNC
    for (int rep_ = 0; rep_ < EXTRA_SYNC; ++rep_) GRID_BAR();
#endif
    if ((int)blockIdx.x == G - 1 && tid < 256) ((float*)(ws + WS_GT))[tid] = p.in[8 + (tid >> 6)][tid & 63];
    if (G > 128) { if (blockIdx.x < 96) p0_mod(p, L, tid, wave, lane); else p0_weights(p, L, (blockIdx.x - 96) * NWAVES + wave, (G - 96) * NWAVES, wave, lane); }
    else { if (blockIdx.x < 96) p0_mod(p, L, tid, wave, lane); p0_weights(p, L, gw, ngw, wave, lane); }
    GRID_BAR();
    p0b_rows(p, L, tid, gw, ngw, lane);
    p0b_c2(p, L, tid, gw, ngw, lane);
    GRID_BAR();
#ifndef NO_P1
    for (int rep_ = 0; rep_ < REP_P1; ++rep_) {
    {
        pg8::Gemm g{XN, Wt_in, MROWS, NQKV, DM}; pg8::StaticOrder S; S.init(MROWS, NQKV, G, (int)blockIdx.x);
        pg8::EpiInProj E{QKV, (const float*)(ws + WS_GT), kmp};
        pg8::gemm_phase<pg8::EpiInProj, pg8::StaticOrder, true, true>(L, g, S, E);
    }
    if (rep_ + 1 < REP_P1) GRID_BAR(); }
#endif
    GRID_BAR();
#ifndef NO_P2
    for (int rep_ = 0; rep_ < REP_P2; ++rep_) {
    {
        const int vcu = (G % 8 == 0) ? (int)(blockIdx.x % 8) * (G / 8) + (int)(blockIdx.x / 8) : (int)blockIdx.x;
        const int xg = (vcu * 8) / G;
        const attn_body::bf16* qkv = (const attn_body::bf16*)QKV; attn_body::bf16* att = (attn_body::bf16*)ATT;
        const attn_body::u32x2v* kaug = (const attn_body::u32x2v*)(ws + WS_KAUG); const float* fl2 = (const float*)(ws + WS_FL2); const float* gt = (const float*)(ws + WS_GT);
        const int* t0tab = (const int*)(ws + WS_T0);
        if (rep_ == 0 && blockIdx.x < 64) { p1_scan(p, L, tid); flag_arrive((unsigned*)(ws + WS_CTL) + CTL_SCANCNT); }
        {
            unsigned* ctr = (unsigned*)(ws + WS_CTL) + 4096 + 64 * (8 + xg) + 1024 * rep_;
            if (tid == 0) MISC[0] = __hip_atomic_fetch_add(ctr, 1u, __ATOMIC_RELAXED, __HIP_MEMORY_SCOPE_AGENT);
            __syncthreads();
            int cur = (int)MISC[0];
            int pre = 0; attn_body::Seam sm;
#pragma unroll 1
            while (cur < 128) { const int qb = 15 - (cur >> 3), bh = 8 * xg + (cur & 7);
                cur = attn_body::attn_unit<1>(bh >> 3, bh & 7, qb, 0, qkv, kaug, fl2, kmp, p.in[12], gt, T5B, att, (char*)lds, ctr, MISC, pre, t0tab, sm); pre = 1; }
        }
        __syncthreads();
        {
            unsigned* ctr = (unsigned*)(ws + WS_CTL) + 4096 + 64 * xg + 1024 * rep_;
            flag_wait((unsigned*)(ws + WS_CTL) + CTL_SCANCNT, 64u, (unsigned*)(ws + WS_CTL));
            if (tid == 0) MISC[0] = __hip_atomic_fetch_add(ctr, 1u, __ATOMIC_RELAXED, __HIP_MEMORY_SCOPE_AGENT);
            __syncthreads();
            int cur = (int)MISC[0];
            int pre = 0; attn_body::Seam sm;
            if (tid < 128) ((LAS int*)(L + attn_body::LDS_TAB))[tid] = t0tab[xg * 128 + tid];
            __syncthreads();
#pragma unroll 1
            while (cur < 128) { const int qb = 15 - (cur >> 3), bh = 8 * xg + (cur & 7);
                const int T0 = __builtin_amdgcn_readfirstlane(((const LAS int*)(L + attn_body::LDS_TAB))[(cur & 7) * 16 + qb]);
                cur = attn_body::attn_unit<0>(bh >> 3, bh & 7, qb, T0, qkv, kaug, fl2, kmp, p.in[12], gt, T5B, att, (char*)lds, ctr, MISC, pre, t0tab, sm); pre = 1; }
        }
    }
    if (rep_ + 1 < REP_P2) GRID_BAR(); }
#endif
    GRID_BAR();
#ifndef NO_P3
    for (int rep_ = 0; rep_ < REP_P3; ++rep_) {
    {
        pg8::Gemm g{ATT, Wt_o, MROWS, DM, DM}; pg8::StaticOrder S; S.init(MROWS, DM, G, (int)blockIdx.x);
        pg8::EpiWo E{p.in[0], p.out, XN, mod, p.in[5], rsq, (bf16_t*)(ws + WS_X1B)};
        pg8::gemm_phase<pg8::EpiWo, pg8::StaticOrder, true, true>(L, g, S, E);
    }
    if (rep_ + 1 < REP_P3) GRID_BAR(); }
#endif
    GRID_BAR();
#ifndef NO_P4
    for (int rep_ = 0; rep_ < REP_P4; ++rep_) {
    {
        pg8::Gemm g{XN, Wt_gu, MROWS, NGU, DM}; pg8::StaticOrder S; S.init(MROWS, NGU, G, (int)blockIdx.x);
        pg8::EpiSwiGLU E{Hb, c2, rsq, L + EXT_OFF};
        pg8::gemm_phase<pg8::EpiSwiGLU, pg8::StaticOrder, true, true>(L, g, S, E);
    }
    if (rep_ + 1 < REP_P4) GRID_BAR(); }
#endif
    GRID_BAR();
#ifndef NO_P5
#ifdef REP_P5
    {
        pg8::Gemm g{Hb, Wt_dn, MROWS, DM, DFF}; pg8::StaticOrder S; S.init(MROWS, DM, G, (int)blockIdx.x);
        pg8::EpiDown E{p.out, (float*)(ws + 384 * MiB), mod, (const bf16_t*)(ws + WS_X1B)};
        pg8::gemm_phase<pg8::EpiDown, pg8::StaticOrder, true, true>(L, g, S, E);
    }
    GRID_BAR();
#endif
    {
        pg8::Gemm g{Hb, Wt_dn, MROWS, DM, DFF}; pg8::StaticOrder S; S.init(MROWS, DM, G, (int)blockIdx.x);
        pg8::EpiDown E{p.out, p.out, mod, (const bf16_t*)(ws + WS_X1B)};
        pg8::gemm_phase<pg8::EpiDown, pg8::StaticOrder, true, true>(L, g, S, E);
    }
#endif
}

extern "C" void kernel_launch(void* const* d_in, const int* in_sizes, int n_in, void* d_out, int out_size, void* d_ws, size_t ws_size, hipStream_t stream) {
    static int grid = 0;
    if (grid == 0) {
        int dev = 0, cus = 0, per_cu = 0;
        hipGetDevice(&dev);
        hipDeviceGetAttribute(&cus, hipDeviceAttributeMultiprocessorCount, dev);
        hipFuncSetAttribute((const void*)mega_fwd, hipFuncAttributeMaxDynamicSharedMemorySize, LDS_BYTES);
        hipOccupancyMaxActiveBlocksPerMultiprocessor(&per_cu, (const void*)mega_fwd, NTHREADS, LDS_BYTES);
        if (per_cu < 1) { fprintf(stderr, "kernel_launch: occupancy query says %d blocks/CU\n", per_cu); per_cu = 1; }
        if (per_cu > 1) per_cu = 1;
        grid = cus * per_cu;
        if (n_in != 17 || ws_size < WS_END) fprintf(stderr, "kernel_launch: unexpected n_in %d / ws_size %zu\n", n_in, ws_size);
    }
    Params p{};
    for (int i = 0; i < 17; ++i) p.in[i] = (const float*)d_in[i];
    p.out = (float*)d_out; p.ws = (unsigned char*)d_ws;
    if (hipMemsetAsync((char*)d_ws + WS_CTL, 0, CTL_BYTES, stream) != hipSuccess) fprintf(stderr, "kernel_launch: memset of the barrier words failed\n");
    void* args[] = {&p};
    hipError_t e = hipLaunchCooperativeKernel((const void*)mega_fwd, dim3(grid), dim3(NTHREADS), args, LDS_BYTES, stream);
    if (e != hipSuccess) fprintf(stderr, "launch failed: %s (grid %d)\n", hipGetErrorString(e), grid);
}
```

```cpp
#include <hip/hip_runtime.h>
#include <hip/hip_cooperative_groups.h>
#include <cstdio>
#include <cstdint>
namespace cg = cooperative_groups;
#ifndef X1_BF16
#define X1_BF16 1
#endif
#define NT_X 1
#define NT_RL 1
#define NT_P0 1
#define NT_Q 1

constexpr int NB = 8, SEQ = 4096, DM = 1024, MROWS = NB * SEQ, DH = 64, INC = 3080, DFF = 2816, NQKV = 3072, NGU = 2 * DFF;
constexpr float EPS = 1e-6f;
constexpr float LOG2E = 1.4426950408889634f;
constexpr float QSCALE = 0.125f * LOG2E;
constexpr size_t MiB = 1u << 20;
constexpr size_t WS_MOD = 0;
constexpr size_t WS_C2 = 256 * 1024;
constexpr size_t WS_GT = 448 * 1024;
constexpr size_t WS_T0 = 452 * 1024;
constexpr size_t WS_CTL = 512 * 1024, CTL_BYTES = 32768;
constexpr size_t WS_LOGF = 1 * MiB;
constexpr size_t WS_FL2 = 2 * MiB;
constexpr size_t WS_KAUG = 3 * MiB;
constexpr size_t WS_KMP = 5 * MiB;
constexpr size_t WS_RSQ = 6 * MiB;
constexpr size_t WS_WIN = 8 * MiB, WS_WO = 14 * MiB, WS_WGU = 16 * MiB, WS_WDN = 28 * MiB;
constexpr size_t WS_XN = 64 * MiB;
constexpr size_t WS_QKV = 128 * MiB;
constexpr size_t WS_H = 128 * MiB;
constexpr size_t WS_ATT = 320 * MiB;
constexpr size_t WS_X1B = 448 * MiB;
constexpr size_t WS_END = 512 * MiB;

typedef float f32x4 __attribute__((ext_vector_type(4)));
typedef unsigned u32x2 __attribute__((ext_vector_type(2)));
typedef unsigned u32x4 __attribute__((ext_vector_type(4)));

__device__ const unsigned char T5B[128] = {0, 1, 2, 3, 4, 5, 6, 7, 8, 9, 10, 11, 12, 13, 14, 15, 16, 16, 16, 17, 17, 18, 18, 18, 19, 19, 19, 20, 20, 20, 20, 21, 21, 21, 21, 22, 22, 22, 22, 22, 23, 23, 23, 23, 23, 23, 24, 24, 24, 24, 24, 24, 25, 25, 25, 25, 25, 25, 25, 26, 26, 26, 26, 26, 26, 26, 26, 27, 27, 27, 27, 27, 27, 27, 27, 27, 27, 28, 28, 28, 28, 28, 28, 28, 28, 28, 28, 29, 29, 29, 29, 29, 29, 29, 29, 29, 29, 29, 29, 30, 30, 30, 30, 30, 30, 30, 30, 30, 30, 30, 30, 30, 30, 31, 31, 31, 31, 31, 31, 31, 31, 31, 31, 31, 31, 31, 31, 31};

__device__ __forceinline__ unsigned f2bf(float f) { unsigned u = __float_as_uint(f); return (u + 0x7fffu + ((u >> 16) & 1u)) >> 16; }
typedef float f32x2_hw __attribute__((ext_vector_type(2))); typedef __bf16 bf16x2_hw __attribute__((ext_vector_type(2)));
__device__ __forceinline__ unsigned pk2(float lo, float hi) { const f32x2_hw v = {lo, hi}; return __builtin_bit_cast(unsigned, __builtin_convertvector(v, bf16x2_hw)); }
__device__ __forceinline__ float bf2f(unsigned h) { return __uint_as_float(h << 16); }
template <int CTRL> __device__ __forceinline__ float dppf(float v) { return __builtin_bit_cast(float, __builtin_amdgcn_update_dpp(0, __builtin_bit_cast(int, v), CTRL, 0xf, 0xf, true)); }
__device__ __forceinline__ float lx1(float v) { return dppf<0xB1>(v); }
__device__ __forceinline__ float lx2(float v) { return dppf<0x4E>(v); }
__device__ __forceinline__ float lx4(float v, bool bit2) { const float up = dppf<0x104>(v), dn = dppf<0x114>(v); return bit2 ? dn : up; }
__device__ __forceinline__ float lx8(float v) { return dppf<0x128>(v); }
__device__ __forceinline__ float addx16(float v) { auto r = __builtin_amdgcn_permlane16_swap(__float_as_uint(v), __float_as_uint(v), false, false); return __uint_as_float(r[0]) + __uint_as_float(r[1]); }
__device__ __forceinline__ float addx32(float v) { auto r = __builtin_amdgcn_permlane32_swap(__float_as_uint(v), __float_as_uint(v), false, false); return __uint_as_float(r[0]) + __uint_as_float(r[1]); }
__device__ __forceinline__ float wave_sum(float v) {
    v += lx1(v); v += lx2(v); v += dppf<0x141>(v)  ; v += dppf<0x140>(v)  ; v = addx16(v); v = addx32(v);
    return v;
}
#ifndef PG8_WGM
#define PG8_WGM 4
#endif
namespace pg8 {
#define PG8_LAS __attribute__((address_space(3)))
typedef unsigned short bf16_t;
typedef short bf16x8 __attribute__((ext_vector_type(8)));
typedef float f32x4 __attribute__((ext_vector_type(4)));
typedef unsigned u32x4 __attribute__((ext_vector_type(4)));
constexpr int BM = 256, BK = 64, HALF = 128, HTB = HALF * BK * 2  , STAGE_BYTES = 8 * HTB, NXCD = 8, WGM = PG8_WGM;

__host__ __device__ __forceinline__ int lds_byte(int r, int c) { const int st = (r >> 4) * 2 + (c >> 5), rr = r & 15, cc = c & 31, ob = rr * 64 + cc * 2; return st * 1024 + (ob ^ (((ob >> 9) & 1) << 5)); }
__host__ __device__ __forceinline__ void stage_rc(int b, int& R, int& C) { const int st = b / 1024, sb = b % 1024, swz = sb ^ (((sb >> 9) & 1) << 5); R = (st >> 1) * 16 + swz / 64; C = (st & 1) * 32 + (swz % 64) / 2; }
__host__ __device__ __forceinline__ int perm32(int rho) { const int n = rho >> 4, i = rho & 15; return 8 * (i >> 2) + 4 * n + (i & 3); }

struct Unit { int pm, pn; };
struct Gemm { const bf16_t* A; const bf16_t* Bt; int M, N, K; };

struct StaticOrder {
    int nM, nN, nwg, G, c;
    __host__ __device__ void init(int M, int N, int G_, int c_) { nM = M / BM; nN = N / BM; nwg = nM * nN; G = G_; c = c_; }
    __host__ __device__ bool next(int i, Unit& u) const {
        const long L = (long)i * G + c; if (L >= nwg) return false;
        int wgid = (int)L; { const int q = nwg / NXCD, r = nwg % NXCD, xcd = wgid % NXCD, off = wgid / NXCD; wgid = (xcd < r ? xcd * (q + 1) : r * (q + 1) + (xcd - r) * q) + off; }
        const int nig = WGM * nN, gid = wgid / nig, fm = gid * WGM, gsz = (nM - fm) < WGM ? (nM - fm) : WGM;
        u.pm = fm + ((wgid % nig) % gsz); u.pn = (wgid % nig) / gsz; return true;
    }
    __device__ __forceinline__ void a_ready(const Unit&) const {}
    __device__ __forceinline__ void done(const Unit&) const {}
};
__device__ __forceinline__ unsigned cvt_pk_bf16(float lo, float hi) { unsigned r; asm volatile("v_cvt_pk_bf16_f32 %0, %1, %2" : "=v"(r) : "v"(lo), "v"(hi)); return r; }
typedef float f32x2 __attribute__((ext_vector_type(2)));
#ifdef NT_X
#define LDXE(p) __builtin_nontemporal_load((const f32x4*)(p))
#else
#define LDXE(p) (*(const f32x4*)(p))
#endif
#ifdef NT_RL
#define NT_LD16(p) __builtin_nontemporal_load((const u32x4*)(p))
#else
#define NT_LD16(p) (*(const u32x4*)(p))
#endif
#ifdef NT_RS
#define NT_ST16(p, v) __builtin_nontemporal_store((v), (u32x4*)(p))
#else
#define NT_ST16(p, v) (*(u32x4*)(p) = (v))
#endif
#ifdef NT_RO
#define NT_ST16F(p, v) __builtin_nontemporal_store((v), (f32x4*)(p))
#else
#define NT_ST16F(p, v) (*(f32x4*)(p) = (v))
#endif
struct EpiInProj {
    static constexpr bool PERM = true, AFTER_DRAIN = false, PRELOAD = false; static constexpr int NSTORE = 16;
    bf16_t* O; const float* gtab; float* kmp;
    __device__ __forceinline__ void operator()(const f32x4 (&acc)[2][2][4][2], const Unit& u, int wr, int wc, int fr, int fq) const {
        const int sec = u.pn >> 1, head = 4 * (u.pn & 1) + wc;
        const bool nrm = (sec != 2 && sec != 5);
        const float* gp = gtab + 64 * (sec - (sec >= 3 ? 1 : 0));
        const float qs = (sec == 0 || sec == 3) ? QSCALE : 1.f;
        f32x4 gv[2][2]; float rinvs[2][4];
#pragma unroll
        for (int bj = 0; bj < 2; ++bj)
#pragma unroll
            for (int n = 0; n < 2; ++n) gv[bj][n] = nrm ? *(const f32x4*)(gp + 32 * bj + 8 * fq + 4 * n) * qs : (f32x4){1.f, 1.f, 1.f, 1.f};
        bf16_t* obase = O + (size_t)(u.pm * BM + wr * 64 + fr) * NQKV + 512 * sec + 64 * head + 8 * fq;
#pragma unroll
        for (int ai = 0; ai < 2; ++ai)
#pragma unroll
            for (int m = 0; m < 4; ++m) {
                float rinv = 1.f;
                if (nrm) {
                    typedef float f32x2_ __attribute__((ext_vector_type(2)));
                    f32x2_ s2 = {0.f, 0.f}, s3 = {0.f, 0.f};
#pragma unroll
                    for (int bj = 0; bj < 2; ++bj)
#pragma unroll
                        for (int n = 0; n < 2; ++n) { const f32x4 v = acc[ai][bj][m][n]; const f32x2_ a = {v[0], v[1]}, b = {v[2], v[3]}; s2 = __builtin_elementwise_fma(a, a, s2); s3 = __builtin_elementwise_fma(b, b, s3); }
                    float ss = (s2.x + s2.y) + (s3.x + s3.y);
                    ss = ::addx16(ss); ss = ::addx32(ss);
                    rinv = __builtin_amdgcn_rsqf(ss * (1.0f / 64.0f) + EPS);
                }
                rinvs[ai][m] = rinv;
                bf16_t* rowp = obase + (size_t)(ai * HALF + m * 16) * NQKV;
#pragma unroll
                for (int bj = 0; bj < 2; ++bj) {
                    const f32x4 v0 = acc[ai][bj][m][0] * rinv * gv[bj][0], v1 = acc[ai][bj][m][1] * rinv * gv[bj][1];
                    u32x4 w; w.x = cvt_pk_bf16(v0[0], v0[1]); w.y = cvt_pk_bf16(v0[2], v0[3]); w.z = cvt_pk_bf16(v1[0], v1[1]); w.w = cvt_pk_bf16(v1[2], v1[3]);
                    *(u32x4*)(rowp + 32 * bj) = w;
                }
            }
        if (sec == 4) {
            const int b = u.pm >> 4, nblk = u.pm & 15;
            float* dst = kmp + ((size_t)(((b * 8 + head) * 16 + nblk) * 2 + wr)) * 64 + 8 * fq;
#pragma unroll
            for (int bj = 0; bj < 2; ++bj)
#pragma unroll
                for (int n = 0; n < 2; ++n) {
                    f32x4 cs = (f32x4){0.f, 0.f, 0.f, 0.f};
#pragma unroll
                    for (int ai = 0; ai < 2; ++ai)
#pragma unroll
                        for (int m = 0; m < 4; ++m) cs += acc[ai][bj][m][n] * rinvs[ai][m];
                    cs *= gv[bj][n];
#pragma unroll
                    for (int e = 0; e < 4; ++e) { float t = cs[e]; t += ::lx1(t); t += ::lx2(t); t += ::dppf<0x141>(t); t += ::dppf<0x140>(t); cs[e] = t; }
                    if (fr == 0) *(f32x4*)(dst + 32 * bj + 4 * n) = cs;
                }
        }
    }
};
struct EpiWo {
    static constexpr bool PERM = true, AFTER_DRAIN = false, PRELOAD = false; static constexpr int NSTORE = 18;
    const float* x; float* out; bf16_t* xn; const float* mod; const float* norm2; float* rsq; bf16_t* x1b;
    __device__ __forceinline__ void operator()(const f32x4 (&acc)[2][2][4][2], const Unit& u, int wr, int wc, int fr, int fq) const {
        const int b = u.pm >> 4, col0 = u.pn * BM + wc * 32 + 8 * fq;
        f32x4 g1[2][2], gm[2][2];
#pragma unroll
        for (int bj = 0; bj < 2; ++bj)
#pragma unroll
            for (int n = 0; n < 2; ++n) { const int c = col0 + bj * HALF + 4 * n;
                g1[bj][n] = *(const f32x4*)(mod + b * 6144 + 2 * 1024 + c);
                gm[bj][n] = *(const f32x4*)(norm2 + c) * (*(const f32x4*)(mod + b * 6144 + 4 * 1024 + c) + 1.0f); }
#pragma unroll
        for (int am = 0; am < 8; am += 2) {
            f32x4 xv[2][2][2];
#pragma unroll
            for (int q = 0; q < 2; ++q) { const int ai = (am + q) >> 2, m = (am + q) & 3; const size_t off = (size_t)(u.pm * BM + ai * HALF + wr * 64 + m * 16 + fr) * DM + col0;
#pragma unroll
                for (int bj = 0; bj < 2; ++bj)
#pragma unroll
                    for (int n = 0; n < 2; ++n) xv[q][bj][n] = LDXE(x + off + bj * HALF + 4 * n); }
            asm volatile("" ::: "memory");
#pragma unroll
            for (int q = 0; q < 2; ++q) {
                const int ai = (am + q) >> 2, m = (am + q) & 3;
                const int row = u.pm * BM + ai * HALF + wr * 64 + m * 16 + fr; const size_t off = (size_t)row * DM + col0; float ss = 0.f;
#pragma unroll
                for (int bj = 0; bj < 2; ++bj) {
                    const f32x4 a0 = xv[q][bj][0] + g1[bj][0] * acc[ai][bj][m][0], a1 = xv[q][bj][1] + g1[bj][1] * acc[ai][bj][m][1];
#if X1_BF16
                    { u32x4 wx; wx.x = cvt_pk_bf16(a0[0], a0[1]); wx.y = cvt_pk_bf16(a0[2], a0[3]); wx.z = cvt_pk_bf16(a1[0], a1[1]); wx.w = cvt_pk_bf16(a1[2], a1[3]); NT_ST16(x1b + off + bj * HALF, wx); }
#else
                    *(f32x4*)(out + off + bj * HALF) = a0; *(f32x4*)(out + off + bj * HALF + 4) = a1;
#endif
                    { typedef float f32x2_ __attribute__((ext_vector_type(2))); const f32x2_ p0 = {a0[0], a0[1]}, p1 = {a0[2], a0[3]}, p2 = {a1[0], a1[1]}, p3 = {a1[2], a1[3]};
                      f32x2_ q = p0 * p0; q = __builtin_elementwise_fma(p1, p1, q); f32x2_ q2 = p2 * p2; q2 = __builtin_elementwise_fma(p3, p3, q2); q += q2; ss += q.x + q.y; }
                    const f32x4 y0 = a0 * gm[bj][0], y1 = a1 * gm[bj][1];
                    u32x4 wy; wy.x = cvt_pk_bf16(y0[0], y0[1]); wy.y = cvt_pk_bf16(y0[2], y0[3]); wy.z = cvt_pk_bf16(y1[0], y1[1]); wy.w = cvt_pk_bf16(y1[2], y1[3]);
                    *(u32x4*)(xn + off + bj * HALF) = wy;
                }
                ss = ::addx16(ss); ss = ::addx32(ss);
                if (fq == 0) rsq[(size_t)row * 16 + 4 * u.pn + wc] = ss;
            }
            asm volatile("" ::: "memory");
        }
    }
};
struct EpiSwiGLU {
    static constexpr bool PERM = true, AFTER_DRAIN = false, PRELOAD = true; static constexpr int NSTORE = 8;
    bf16_t* H; const float* c2; const float* rsq; PG8_LAS unsigned char* ext;
    __device__ __forceinline__ void preload(const Unit& u, int wid, int lane) const {
        const char* src = (const char*)(rsq + (size_t)u.pm * BM * 16) + lane * 16;
#pragma unroll
        for (int i = 0; i < 2; ++i) { const int pc = wid * 2 + i; __builtin_amdgcn_global_load_lds((const unsigned*)(src + pc * 1024), (PG8_LAS unsigned*)(ext + pc * 1024), 16, 0, 0); }
        if (wid == 0) __builtin_amdgcn_global_load_lds((const unsigned*)((const char*)(c2 + (u.pm >> 4) * NGU + u.pn * 256) + lane * 16), (PG8_LAS unsigned*)(ext + 16384), 16, 0, 0);
    }
    __device__ __forceinline__ void operator()(const f32x4 (&acc)[2][2][4][2], const Unit& u, int wr, int wc, int fr, int fq) const {
        const int hc = u.pn * 128 + wc * 32 + 8 * fq;
        f32x4 cg[2], cu[2];
        { const PG8_LAS float* cl = (const PG8_LAS float*)(ext + 16384) + wc * 32 + 8 * fq;
#pragma unroll
        for (int n = 0; n < 2; ++n) { cg[n] = *(const PG8_LAS f32x4*)(cl + 4 * n); cu[n] = *(const PG8_LAS f32x4*)(cl + 128 + 4 * n); } }
        f32x4 cgn[2]; cgn[0] = cg[0] * (-LOG2E); cgn[1] = cg[1] * (-LOG2E);
        f32x4 pr[2][4];
#pragma unroll
        for (int ai = 0; ai < 2; ++ai)
#pragma unroll
            for (int m = 0; m < 4; ++m) pr[ai][m] = *(const PG8_LAS f32x4*)(ext + (ai * HALF + wr * 64 + m * 16 + fr) * 64 + 16 * fq);
        float rstd[2][4];
#pragma unroll
        for (int ai = 0; ai < 2; ++ai)
#pragma unroll
            for (int m = 0; m < 4; ++m) { float t = (pr[ai][m][0] + pr[ai][m][1]) + (pr[ai][m][2] + pr[ai][m][3]); t = ::addx16(t); t = ::addx32(t); rstd[ai][m] = __builtin_amdgcn_rsqf(t * (1.0f / 1024.0f) + EPS); }
#pragma unroll
        for (int ai = 0; ai < 2; ++ai)
#pragma unroll
            for (int m = 0; m < 4; ++m) {
                const int row = u.pm * BM + ai * HALF + wr * 64 + m * 16 + fr;
                const float rs = rstd[ai][m], rsn = -rs * LOG2E;
                typedef float f32x2_ __attribute__((ext_vector_type(2)));
                const f32x2_ rs2 = {rs, rs}, rsn2 = {rsn, rsn};
                unsigned wq[4];
#pragma unroll
                for (int n = 0; n < 2; ++n)
#pragma unroll
                    for (int pp = 0; pp < 2; ++pp) {
                        const f32x2_ ag = {acc[ai][0][m][n][2 * pp], acc[ai][0][m][n][2 * pp + 1]}, au = {acc[ai][1][m][n][2 * pp], acc[ai][1][m][n][2 * pp + 1]};
                        const f32x2_ cgp = {cg[n][2 * pp], cg[n][2 * pp + 1]}, cup = {cu[n][2 * pp], cu[n][2 * pp + 1]}, cgnp = {cgn[n][2 * pp], cgn[n][2 * pp + 1]};
                        const f32x2_ g = __builtin_elementwise_fma(ag, rs2, cgp), uu = __builtin_elementwise_fma(au, rs2, cup), ge = __builtin_elementwise_fma(ag, rsn2, cgnp);
                        const f32x2_ e2 = {__builtin_amdgcn_exp2f(ge.x), __builtin_amdgcn_exp2f(ge.y)};
                        const f32x2_ d2 = e2 + 1.0f;
                        const f32x2_ r2 = {__builtin_amdgcn_rcpf(d2.x), __builtin_amdgcn_rcpf(d2.y)};
                        const f32x2_ hp = (g * uu) * r2;
                        wq[2 * n + pp] = cvt_pk_bf16(hp.x, hp.y);
                    }
                u32x4 w; w.x = wq[0]; w.y = wq[1]; w.z = wq[2]; w.w = wq[3];
                *(u32x4*)(H + (size_t)row * DFF + hc) = w;
            }
    }
};
struct EpiDown {
    static constexpr bool PERM = true, AFTER_DRAIN = false, PRELOAD = false; static constexpr int NSTORE = 16;
    const float* xin; float* out; const float* mod; const bf16_t* x1b;
    __device__ __forceinline__ void operator()(const f32x4 (&acc)[2][2][4][2], const Unit& u, int wr, int wc, int fr, int fq) const {
        const int b = u.pm >> 4, col0 = u.pn * BM + wc * 32 + 8 * fq;
        f32x4 g2[2][2];
#pragma unroll
        for (int bj = 0; bj < 2; ++bj)
#pragma unroll
            for (int n = 0; n < 2; ++n) g2[bj][n] = *(const f32x4*)(mod + b * 6144 + 5 * 1024 + col0 + bj * HALF + 4 * n);
#pragma unroll
        for (int ai = 0; ai < 2; ++ai) {
            f32x4 xv[4][2][2];
#pragma unroll
            for (int m = 0; m < 4; ++m) { const size_t off = (size_t)(u.pm * BM + ai * HALF + wr * 64 + m * 16 + fr) * DM + col0;
#pragma unroll
                for (int bj = 0; bj < 2; ++bj) {
#if X1_BF16
                    const u32x4 wx = NT_LD16(x1b + off + bj * HALF);
                    xv[m][bj][0] = (f32x4){__uint_as_float(wx.x << 16), __uint_as_float(wx.x & 0xffff0000u), __uint_as_float(wx.y << 16), __uint_as_float(wx.y & 0xffff0000u)};
                    xv[m][bj][1] = (f32x4){__uint_as_float(wx.z << 16), __uint_as_float(wx.z & 0xffff0000u), __uint_as_float(wx.w << 16), __uint_as_float(wx.w & 0xffff0000u)};
#else
                    xv[m][bj][0] = *(const f32x4*)(xin + off + bj * HALF); xv[m][bj][1] = *(const f32x4*)(xin + off + bj * HALF + 4);
#endif
                } }
            asm volatile("" ::: "memory");
#pragma unroll
            for (int m = 0; m < 4; ++m) { const size_t off = (size_t)(u.pm * BM + ai * HALF + wr * 64 + m * 16 + fr) * DM + col0;
#pragma unroll
                for (int bj = 0; bj < 2; ++bj)
#pragma unroll
                    for (int n = 0; n < 2; ++n) NT_ST16F(out + off + bj * HALF + 4 * n, xv[m][bj][n] + g2[bj][n] * acc[ai][bj][m][n]); }
            asm volatile("" ::: "memory");
        }
    }
};

template <class Epi, class Sched, bool ALIGN_EPI = false, bool SP2 = false>
__device__ __forceinline__ void gemm_phase(PG8_LAS unsigned char* lds, const Gemm g, const Sched& S, const Epi& E) {
    int tid_ = threadIdx.x; asm volatile("" : "+v"(tid_));
    const int tid = tid_, wid = __builtin_amdgcn_readfirstlane(tid >> 6), lane = tid & 63, wr = wid >> 2, wc = wid & 3, fr = lane & 15, fq = lane >> 4;
    const int K = g.K, nt = K / BK;
    unsigned voffA[2], voffB[2];
#pragma unroll
    for (int i = 0; i < 2; ++i) { int R, C; stage_rc(tid * 16 + i * 8192, R, C); const int Rb = Epi::PERM ? ((R & ~31) + perm32(R & 31)) : R;
        voffA[i] = (unsigned)(R * K + C) * 2u; voffB[i] = (unsigned)(Rb * K + C) * 2u; }
    const size_t kstep = (size_t)(BK * 2);
    const size_t hstep = (size_t)HALF * K * 2;
    const size_t tstep = 2 * hstep;
    const unsigned ldsw = (unsigned)wid * 1024u;
    const int aoff = lds_byte(wr * 64 + fr, fq * 8), boff = lds_byte(wc * 32 + fr, fq * 8);
#define PG8_SA(b, h) (((b) * 2 + (h)) * HTB)
#define PG8_SB(b, h) ((4 + (b) * 2 + (h)) * HTB)
#define PG8_STAGE(bufoff, gbase, voff) do { _Pragma("unroll") for (int _i = 0; _i < 2; ++_i) \
        __builtin_amdgcn_global_load_lds((const unsigned*)((const char*)(gbase) + (voff)[_i]), (PG8_LAS unsigned*)(lds + (bufoff) + ldsw + _i * 8192), 16, 0, 0); } while (0)
#define PG8_LDA(dst, b, h) do { _Pragma("unroll") for (int m = 0; m < 4; ++m) _Pragma("unroll") for (int k = 0; k < 2; ++k) dst[m][k] = *(const PG8_LAS bf16x8*)(lds + PG8_SA(b, h) + aoff + m * 2048 + k * 1024); } while (0)
#define PG8_LDB(dst, b, h) do { _Pragma("unroll") for (int n = 0; n < 2; ++n) _Pragma("unroll") for (int k = 0; k < 2; ++k) dst[n][k] = *(const PG8_LAS bf16x8*)(lds + PG8_SB(b, h) + boff + n * 2048 + k * 1024); } while (0)
#define PG8_MMA(ai, bj, At, Bt) do { __builtin_amdgcn_s_setprio(1); _Pragma("unroll") for (int m = 0; m < 4; ++m) _Pragma("unroll") for (int n = 0; n < 2; ++n) _Pragma("unroll") for (int k = 0; k < 2; ++k) \
        acc[ai][bj][m][n] = __builtin_amdgcn_mfma_f32_16x16x32_bf16(Bt[n][k], At[m][k], acc[ai][bj][m][n], 0, 0, 0); __builtin_amdgcn_s_setprio(0); } while (0)
#define PG8_WAIT_V(n) asm volatile("s_waitcnt vmcnt(" #n ")" ::: "memory")
#define PG8_WAIT_L(n) asm volatile("s_waitcnt lgkmcnt(" #n ")" ::: "memory")
#define PG8_BAR __builtin_amdgcn_s_barrier()
#define PG8_SCHED __builtin_amdgcn_sched_barrier(0)
    Unit cur, nxt; int ui = 0;
    if (!S.next(0, cur)) return;
    f32x4 acc[2][2][4][2];
#pragma unroll
    for (int a = 0; a < 2; ++a)
#pragma unroll
        for (int b = 0; b < 2; ++b)
#pragma unroll
            for (int m = 0; m < 4; ++m)
#pragma unroll
                for (int n = 0; n < 2; ++n) acc[a][b][m][n] = (f32x4){0.f, 0.f, 0.f, 0.f};
    bf16x8 At[4][2], B0[2][2], B1[2][2];
    const char* cA = (const char*)g.A + (size_t)cur.pm * tstep; const char* cB = (const char*)g.Bt + (size_t)cur.pn * tstep;
    S.a_ready(cur);
    if constexpr (SP2) {
        PG8_STAGE(PG8_SB(0, 0), cB, voffB); PG8_STAGE(PG8_SB(0, 1), cB + hstep, voffB); PG8_STAGE(PG8_SA(0, 0), cA, voffA); PG8_STAGE(PG8_SA(0, 1), cA + hstep, voffA);
        if (wr == 1) PG8_BAR;
        PG8_WAIT_V(2); PG8_BAR;
        PG8_STAGE(PG8_SB(1, 0), cB + kstep, voffB); PG8_STAGE(PG8_SA(1, 0), cA + kstep, voffA); PG8_STAGE(PG8_SB(1, 1), cB + hstep + kstep, voffB);
        PG8_WAIT_V(6); PG8_BAR;
    } else {
        PG8_STAGE(PG8_SB(0, 0), cB, voffB); PG8_STAGE(PG8_SA(0, 0), cA, voffA); PG8_STAGE(PG8_SB(0, 1), cB + hstep, voffB); PG8_STAGE(PG8_SA(0, 1), cA + hstep, voffA);
        if (wr == 1) PG8_BAR;
        PG8_WAIT_V(4); PG8_BAR;
        PG8_STAGE(PG8_SB(1, 0), cB + kstep, voffB); PG8_STAGE(PG8_SA(1, 0), cA + kstep, voffA); PG8_STAGE(PG8_SB(1, 1), cB + hstep + kstep, voffB);
        PG8_WAIT_V(6); PG8_BAR;
    }
    for (;;) {
        const bool has_next = S.next(ui + 1, nxt);
        const char* nA = has_next ? (const char*)g.A + (size_t)nxt.pm * tstep : cA; const char* nB = has_next ? (const char*)g.Bt + (size_t)nxt.pn * tstep : cB;
        for (int t = 0; t < nt; t += 2) {
            const bool last = (t == nt - 2);
            const char* a1 = cA + (size_t)(t + 1) * kstep;
            const char* a2 = last ? nA : cA + (size_t)(t + 2) * kstep; const char* b2 = last ? nB : cB + (size_t)(t + 2) * kstep;
            const char* a3 = a2 + kstep; const char* b3 = b2 + kstep;
            if (last && has_next) S.a_ready(nxt);
            if constexpr (Epi::PRELOAD) { if (t == nt - 4) E.preload(cur, wid, lane); }
            if constexpr (SP2) {
            PG8_LDB(B0, 0, 0); PG8_LDB(B1, 0, 1); PG8_SCHED; PG8_LDA(At, 0, 0); PG8_STAGE(PG8_SA(1, 1), a1 + hstep, voffA);
            PG8_WAIT_V(8); PG8_WAIT_L(0); PG8_BAR; PG8_MMA(0, 0, At, B0); PG8_MMA(0, 1, At, B1); PG8_BAR; PG8_SCHED;
            PG8_LDA(At, 0, 1); PG8_STAGE(PG8_SB(0, 0), b2, voffB); PG8_STAGE(PG8_SB(0, 1), b2 + hstep, voffB); PG8_STAGE(PG8_SA(0, 0), a2, voffA);
            PG8_WAIT_V(8); PG8_WAIT_L(0); PG8_BAR; PG8_MMA(1, 0, At, B0); PG8_MMA(1, 1, At, B1); PG8_BAR; PG8_SCHED;
            PG8_LDB(B0, 1, 0); PG8_LDB(B1, 1, 1); PG8_SCHED; PG8_LDA(At, 1, 0); PG8_STAGE(PG8_SA(0, 1), a2 + hstep, voffA);
            PG8_WAIT_V(8); PG8_WAIT_L(0); PG8_BAR; PG8_MMA(0, 0, At, B0); PG8_MMA(0, 1, At, B1); PG8_BAR; PG8_SCHED;
            PG8_LDA(At, 1, 1); PG8_STAGE(PG8_SB(1, 0), b3, voffB); PG8_STAGE(PG8_SB(1, 1), b3 + hstep, voffB); PG8_STAGE(PG8_SA(1, 0), a3, voffA);
            PG8_WAIT_V(8); PG8_WAIT_L(0); PG8_BAR; PG8_MMA(1, 0, At, B0); PG8_MMA(1, 1, At, B1); PG8_BAR; PG8_SCHED;
            } else {
            PG8_LDB(B0, 0, 0); PG8_SCHED; PG8_LDA(At, 0, 0); PG8_STAGE(PG8_SA(1, 1), a1 + hstep, voffA);
            PG8_WAIT_L(8); PG8_BAR; PG8_WAIT_L(0); PG8_MMA(0, 0, At, B0); PG8_BAR; PG8_SCHED;
            PG8_LDB(B1, 0, 1); PG8_STAGE(PG8_SB(0, 0), b2, voffB);
            PG8_BAR; PG8_WAIT_L(0); PG8_MMA(0, 1, At, B1); PG8_BAR;
            PG8_LDA(At, 0, 1); PG8_STAGE(PG8_SA(0, 0), a2, voffA);
            PG8_BAR; PG8_WAIT_L(0); PG8_MMA(1, 0, At, B0); PG8_BAR; PG8_SCHED;
            PG8_STAGE(PG8_SB(0, 1), b2 + hstep, voffB);
            PG8_WAIT_V(6); PG8_BAR; PG8_MMA(1, 1, At, B1); PG8_BAR;
            PG8_LDB(B0, 1, 0); PG8_SCHED; PG8_LDA(At, 1, 0); PG8_STAGE(PG8_SA(0, 1), a2 + hstep, voffA);
            PG8_WAIT_L(8); PG8_BAR; PG8_WAIT_L(0); PG8_MMA(0, 0, At, B0); PG8_BAR; PG8_SCHED;
            PG8_LDB(B1, 1, 1); PG8_STAGE(PG8_SB(1, 0), b3, voffB);
            PG8_BAR; PG8_WAIT_L(0); PG8_MMA(0, 1, At, B1); PG8_BAR;
            PG8_LDA(At, 1, 1); PG8_STAGE(PG8_SA(1, 0), a3, voffA);
            PG8_BAR; PG8_WAIT_L(0); PG8_MMA(1, 0, At, B0); PG8_BAR; PG8_SCHED;
            PG8_STAGE(PG8_SB(1, 1), b3 + hstep, voffB);
            PG8_WAIT_V(6); PG8_BAR; PG8_MMA(1, 1, At, B1); PG8_BAR;
            }
        }
        if constexpr (ALIGN_EPI) { if (wr == 0) PG8_BAR; }
        if constexpr (!Epi::AFTER_DRAIN) { E(acc, cur, wr, wc, fr, fq); S.done(cur); }
        if (!has_next) break;
#pragma unroll
        for (int a = 0; a < 2; ++a)
#pragma unroll
            for (int b = 0; b < 2; ++b)
#pragma unroll
                for (int m = 0; m < 4; ++m)
#pragma unroll
                    for (int n = 0; n < 2; ++n) acc[a][b][m][n] = (f32x4){0.f, 0.f, 0.f, 0.f};
        cur = nxt; cA = nA; cB = nB; ++ui;
        if constexpr (ALIGN_EPI) { if (wr == 1) PG8_BAR; }
    }
    PG8_WAIT_V(0);
    if constexpr (!ALIGN_EPI) { if (wr == 0) PG8_BAR; }
    PG8_BAR;
    if constexpr (Epi::AFTER_DRAIN) { E.fused(acc, cur, wr, wc, fr, fq, lds, wid, lane); S.done(cur); }
#undef PG8_SA
#undef PG8_SB
#undef PG8_STAGE
#undef PG8_LDA
#undef PG8_LDB
#undef PG8_MMA
#undef PG8_WAIT_V
#undef PG8_WAIT_L
#undef PG8_BAR
#undef PG8_SCHED
}
}
#include <hip/hip_bf16.h>
#ifndef SKIP_MODES
#define SKIP_MODES(M) ((M)==1)
#endif
namespace attn_body {
using bf16=__hip_bfloat16;
using bf16x8=__attribute__((ext_vector_type(8)))short;
using s16x4=__attribute__((ext_vector_type(4)))short;
using f32x16=__attribute__((ext_vector_type(16)))float;
using f32x4v=__attribute__((ext_vector_type(4)))float;
using u32x4=__attribute__((ext_vector_type(4)))unsigned;
using u32x2v=__attribute__((ext_vector_type(2)))unsigned;
constexpr int NHEAD=8,SEQ=4096,D=64,QP=3072,OP=1024;
constexpr int NW=8,QBLK=32,QB=QBLK*NW,KVBLK=64;
__device__ __forceinline__ int crow(int r,int hi){return (r&3)+8*(r>>2)+4*hi;}
#define SBAR() __builtin_amdgcn_sched_barrier(0)
typedef __attribute__((address_space(3))) const char* lds_cptr;
typedef __attribute__((address_space(3))) const float* lds_fptr;
typedef __attribute__((address_space(3))) const unsigned* lds_uptr;
__device__ __forceinline__ void cmask(f32x16&p0,f32x16&p1,int jb,int qrel,int hi){
  const float NEG=-INFINITY; int kb=64*jb+4*hi;
  #pragma unroll
  for(int r=0;r<16;++r){int kv=kb+(r&3)+8*(r>>2); if(kv>qrel)p0[r]=NEG; if(kv+32>qrel)p1[r]=NEG;}
}
__device__ __forceinline__ void bias_add(f32x16&p0,f32x16&p1,int jb,int qrel,int hi,lds_fptr tab){
  const int base=qrel-64*jb-4*hi;
  #pragma unroll
  for(int r=0;r<16;++r){const int d0=base-((r&3)+8*(r>>2)),d1=d0-32; p0[r]+=tab[d0<0?0:d0]; p1[r]+=tab[d1<0?0:d1];}
}

constexpr int NSLOT=3, SLOTB=8192;
constexpr int LDS_K=0, LDS_V=NSLOT*SLOTB, LDS_WS=2*NSLOT*SLOTB, LDS_OST=LDS_WS+NW*64*4, LDS_FAUG=LDS_OST+NW*4096, LDS_TAB=LDS_FAUG+32768, LDS_KM=LDS_TAB+1536, LDS_BYTES=LDS_KM+4096;
__device__ __forceinline__ void glds16(const void*gsrc,unsigned lds_dst){unsigned keep;
  asm volatile("s_mov_b32 %0, m0\n\ts_mov_b32 m0, %2\n\ts_nop 0\n\tglobal_load_lds_dwordx4 %1, off\n\ts_mov_b32 m0, %0":"=&s"(keep):"v"(gsrc),"s"(lds_dst):"memory");}
typedef float f32x2_t __attribute__((ext_vector_type(2))); typedef __bf16 bf16x2_t __attribute__((ext_vector_type(2)));
__device__ __forceinline__ unsigned cvtpk_s(float lo,float hi){f32x2_t v={lo,hi};bf16x2_t b=__builtin_convertvector(v,bf16x2_t);return __builtin_bit_cast(unsigned,b);}
#define WAIT_BAR(N) asm volatile("s_waitcnt vmcnt(" #N ") lgkmcnt(0)\n\ts_barrier":::"memory")
#define MFMA32(a,b,c) __builtin_amdgcn_mfma_f32_32x32x16_bf16(a,b,c,0,0,0)
__device__ __forceinline__ unsigned split3(float x,unsigned&h2){
  const unsigned a=cvtpk_s(x,0.f)&0xffffu; const float r1=x-__uint_as_float(a<<16);
  const unsigned b=cvtpk_s(r1,0.f)&0xffffu; const float r2=r1-__uint_as_float(b<<16);
  h2=cvtpk_s(r2,0.f)&0xffffu; return a|(b<<16);
}
typedef short v4i16_t __attribute__((ext_vector_type(4)));
__device__ __forceinline__ void kload8(bf16x8*kf,lds_cptr kp){
  kf[0]=*(const __attribute__((address_space(3))) bf16x8*)(kp);      kf[1]=*(const __attribute__((address_space(3))) bf16x8*)(kp+512);
  kf[2]=*(const __attribute__((address_space(3))) bf16x8*)(kp+2048); kf[3]=*(const __attribute__((address_space(3))) bf16x8*)(kp+2560);
  kf[4]=*(const __attribute__((address_space(3))) bf16x8*)(kp+4096); kf[5]=*(const __attribute__((address_space(3))) bf16x8*)(kp+4608);
  kf[6]=*(const __attribute__((address_space(3))) bf16x8*)(kp+6144); kf[7]=*(const __attribute__((address_space(3))) bf16x8*)(kp+6656);
}
__device__ __forceinline__ void kload2(bf16x8*kf,lds_cptr kp,int j){ kf[2*j]=*(const __attribute__((address_space(3))) bf16x8*)(kp+j*2048); kf[2*j+1]=*(const __attribute__((address_space(3))) bf16x8*)(kp+j*2048+512); }
__device__ __forceinline__ s16x4 vtr(lds_cptr p){ return __builtin_bit_cast(s16x4,__builtin_amdgcn_ds_read_tr16_b64_v4i16((__attribute__((address_space(3))) v4i16_t*)p)); }
__device__ __forceinline__ void pv(f32x16*o,int vb,bf16x8 pa0,bf16x8 pa1,bf16x8 pa2,bf16x8 pa3){
  #pragma unroll
  for(int d0=0;d0<2;++d0){s16x4 lo[4],hi[4];
    #pragma unroll
    for(int ks=0;ks<4;++ks){
      asm volatile("ds_read_b64_tr_b16 %0,%1 offset:%c2":"=&v"(lo[ks]):"v"(vb),"i"(d0*4096+ks*1024):"memory");
      asm volatile("ds_read_b64_tr_b16 %0,%1 offset:%c2":"=&v"(hi[ks]):"v"(vb),"i"(d0*4096+ks*1024+512):"memory");}
    asm volatile("s_waitcnt lgkmcnt(0)":::"memory");SBAR();
    #define PK(k) (bf16x8){lo[k][0],lo[k][1],lo[k][2],lo[k][3],hi[k][0],hi[k][1],hi[k][2],hi[k][3]}
    o[d0]=MFMA32(pa0,PK(0),o[d0]);
    o[d0]=MFMA32(pa1,PK(1),o[d0]);
    o[d0]=MFMA32(pa2,PK(2),o[d0]);
    o[d0]=MFMA32(pa3,PK(3),o[d0]);
    #undef PK
  }
}
__device__ __forceinline__ float wmax(float v){
  v=fmaxf(v,::lx1(v)); v=fmaxf(v,::lx2(v)); v=fmaxf(v,::dppf<0x141>(v)); v=fmaxf(v,::dppf<0x140>(v));
  { auto r=__builtin_amdgcn_permlane16_swap(__float_as_uint(v),__float_as_uint(v),false,false); v=fmaxf(__uint_as_float(r[0]),__uint_as_float(r[1])); }
  { auto r=__builtin_amdgcn_permlane32_swap(__float_as_uint(v),__float_as_uint(v),false,false); v=fmaxf(__uint_as_float(r[0]),__uint_as_float(r[1])); }
  return v;
}

struct Seam { bf16x8 q[4]; float tabv, km0, km1, base, r0, r31, fq; };
template<int MODE> __device__ __forceinline__ int attn_unit(int b,int h,int qb,int T0,const bf16*__restrict__ QKV,const u32x2v*__restrict__ Kaug,const float*__restrict__ Fl2,const float*__restrict__ kmp,
                                                            const float*__restrict__ relb,const float*__restrict__ gtab,const unsigned char*__restrict__ t5b,bf16*__restrict__ O,char*shm,unsigned*ctr,volatile __attribute__((address_space(3))) unsigned*misc,int pre,const int*__restrict__ t0tab,Seam&sm){
  int tid_=threadIdx.x; asm volatile("":"+v"(tid_));
  const int tid=tid_,lane=tid&63,r32=lane&31,hi=lane>>5; const int wid=__builtin_amdgcn_readfirstlane(tid>>6);
  const int bh=b*NHEAD+h; const long rowbase=(long)b*SEQ; const int q0=qb*QB;
  const int cq=(MODE?1536:0)+h*D;
  const bf16*Qw=QKV+(rowbase+q0+wid*QBLK)*QP+cq;
  const bf16*Kh=QKV+rowbase*QP+cq+512,*Vh=QKV+rowbase*QP+cq+1024;
  const unsigned lds0=(unsigned)(uintptr_t)shm;
  float*wsf=(float*)(shm+LDS_WS)+wid*64;
  const bf16*ksrc=Kh+(long)(lane+T0*KVBLK)*QP+wid*8;
  const bf16*vsrc=Vh+(long)(16*(wid&3)+(lane>>2)+T0*KVBLK)*QP+(wid>>2)*32+(lane&3)*8;
  const unsigned kdst=lds0+LDS_K+wid*1024, vdst=lds0+LDS_V+wid*1024;
  #define DMA_K(t,slot) glds16(ksrc+(long)(t)*KVBLK*QP,(unsigned)__builtin_amdgcn_readfirstlane(kdst+(slot)))
  #define DMA_V(t,slot) glds16(vsrc+(long)(t)*KVBLK*QP,(unsigned)__builtin_amdgcn_readfirstlane(vdst+(slot)))
  const int vb0=(int)(lds0+LDS_V)+((lane>>4)&1)*32+(lane&3)*8+(4*hi+((lane&15)>>2))*64;
  const char*Kbase=shm+LDS_K; bf16x8 kf[8];
  const lds_cptr shm3=(lds_cptr)shm; const lds_cptr kp0=shm3+LDS_K+hi*1024+r32*16; const lds_cptr vp0=shm3+LDS_V+((lane>>4)&1)*32+(lane&3)*8+(4*hi+((lane&15)>>2))*64;
  const lds_uptr fau=(lds_uptr)(shm3+LDS_FAUG)+128*T0+r32*2+hi;
  const lds_fptr tabp=(lds_fptr)(shm3+LDS_TAB);
  const int NTA=(q0+QB)/KVBLK, NT=NTA-T0;
  unsigned nxt_=0u; if(tid==0)nxt_=__builtin_amdgcn_atomic_inc32(ctr,0xffffffffu,__ATOMIC_RELAXED,"agent");
  if(!pre){DMA_K(0,0);} DMA_V(0,0); if(!pre){DMA_K(1,SLOTB);}
  bf16x8 qr[4];
  if(pre){
    #pragma unroll
    for(int d0=0;d0<4;++d0)qr[d0]=sm.q[d0];
  }else{
    #pragma unroll
    for(int d0=0;d0<4;++d0)qr[d0]=__builtin_nontemporal_load(reinterpret_cast<const bf16x8*>(&Qw[(long)r32*QP+d0*16+hi*8]));
    asm volatile("":"+v"(qr[0]),"+v"(qr[1]),"+v"(qr[2]),"+v"(qr[3]));
  }
  if(MODE==0){
    if(!pre){ const char*src=(const char*)(Kaug+(size_t)bh*SEQ+KVBLK*T0)+lane*16;
      for(int pc=wid;pc<NT/2;pc+=NW)glds16(src+pc*1024,(unsigned)__builtin_amdgcn_readfirstlane(lds0+LDS_FAUG+KVBLK*T0*8+pc*1024)); }
  }else{
    float tv=0.f,k0v,k1v;
    if(pre){ tv=sm.tabv; k0v=sm.km0; k1v=sm.km1; }
    else { if(tid<113)tv=(relb[t5b[tid]*8+h]-relb[31*8+h])*1.4426950408889634f;
      const float*p0=kmp+((size_t)((bh*16+(tid>>6))*2))*64+(tid&63); const float*p1=kmp+((size_t)((bh*16+8+(tid>>6))*2))*64+(tid&63); k0v=p0[0]+p0[64]; k1v=p1[0]+p1[64]; asm volatile("":"+v"(tv),"+v"(k0v),"+v"(k1v)); }
    float*tb=(float*)(shm+LDS_TAB); if(tid<384)tb[tid]=tv;
    float*kmw=(float*)(shm+LDS_KM); kmw[tid]=k0v; kmw[tid+512]=k1v;
  }
  float Bnd,basev;
  if(pre){ basev=sm.base; Bnd=basev;
    if(MODE==1){ const float bv=lane<32?(sm.r0-sm.r31)*1.4426950408889634f:0.f; Bnd+=fmaxf(wmax(bv),0.f); } }
  else { const float gq=fabsf(gtab[(MODE?128:0)+lane]),gk=fabsf(gtab[(MODE?192:64)+lane]);
    basev=64.f*wmax(gq)*wmax(gk)*(0.125f*1.4426950408889634f)*1.02f+0.25f; Bnd=basev;
    if(MODE==1){ const float bv=lane<32?(relb[lane*8+h]-relb[31*8+h])*1.4426950408889634f:0.f; Bnd+=fmaxf(wmax(bv),0.f); } asm volatile("":"+v"(Bnd),"+v"(basev)); }
  basev=__uint_as_float(__builtin_amdgcn_readfirstlane(__float_as_uint(basev)));
  float fq_row=0.f; if(MODE==0){ if(pre)fq_row=sm.fq; else { fq_row=Fl2[(size_t)bh*SEQ+q0+wid*QBLK+r32]; asm volatile("":"+v"(fq_row)); } }
  float l_reg=0.f;f32x16 o[2];o[0]=f32x16{};o[1]=f32x16{};
  const int qrel=wid*QBLK+r32;
  #define BANDMASK(P0,P1,t) do{int jb_=(t)-(NT-4); if(MODE==1&&jb_>=-2&&(32*wid-64*jb_<176))bias_add(P0,P1,jb_,qrel,hi,tabp); if(jb_>=(wid>>1))cmask(P0,P1,jb_,qrel,hi); }while(0)
  f32x16 pA0,pA1,pB0,pB1;
  int sl_prev=0,sl_cur=0,sl_next=SLOTB;
  #define ROT() do{sl_prev=sl_cur;sl_cur=sl_next;sl_next=(sl_next==(NSLOT-1)*SLOTB)?0:sl_next+SLOTB;}while(0)
  if(!pre){DMA_K(2,2*SLOTB);}
  WAIT_BAR(3);
  unsigned smask=1u<<qb;
  if(MODE==1&&qb>0){
    f32x16 g=f32x16{};
    const lds_fptr kmr=(lds_fptr)(shm3+LDS_KM)+(r32&15)*64+8*hi;
    #pragma unroll
    for(int d0=0;d0<4;++d0){
      const f32x4v x0=*(const __attribute__((address_space(3))) f32x4v*)(kmr+16*d0),x1=*(const __attribute__((address_space(3))) f32x4v*)(kmr+16*d0+4);
      u32x4 ah,al;
      ah[0]=cvtpk_s(x0[0],x0[1]);ah[1]=cvtpk_s(x0[2],x0[3]);ah[2]=cvtpk_s(x1[0],x1[1]);ah[3]=cvtpk_s(x1[2],x1[3]);
      al[0]=cvtpk_s(x0[0]-__uint_as_float(ah[0]<<16),x0[1]-__uint_as_float(ah[0]&0xffff0000u));
      al[1]=cvtpk_s(x0[2]-__uint_as_float(ah[1]<<16),x0[3]-__uint_as_float(ah[1]&0xffff0000u));
      al[2]=cvtpk_s(x1[0]-__uint_as_float(ah[2]<<16),x1[1]-__uint_as_float(ah[2]&0xffff0000u));
      al[3]=cvtpk_s(x1[2]-__uint_as_float(ah[3]<<16),x1[3]-__uint_as_float(ah[3]&0xffff0000u));
      g=MFMA32(__builtin_bit_cast(bf16x8,ah),qr[d0],g); g=MFMA32(__builtin_bit_cast(bf16x8,al),qr[d0],g);
    }
    float gv[16];
    #pragma unroll
    for(int r=0;r<8;++r){ const float mine=g[r]; auto sw=__builtin_amdgcn_permlane32_swap(__float_as_uint(mine),__float_as_uint(mine),false,false); const float oth=__uint_as_float(hi?sw[0]:sw[1]); const int n0=(r&3)+8*(r>>2); gv[n0]=hi?oth:mine; gv[n0+4]=hi?mine:oth; }
    #pragma unroll
    for(int pick=0;pick<3;++pick){ float best=-3.0e38f; int bi=-1;
      #pragma unroll
      for(int n=0;n<16;++n){ const bool ok=(n<qb)&&!((smask>>n)&1u); if(ok&&gv[n]>best){best=gv[n];bi=n;} }
      if(bi>=0)smask|=1u<<bi; }
  }
  u32x4 qaug=(u32x4){0u,0u,0u,0u}; u32x4 ka0=(u32x4){0u,0u,0u,0u},ka1=(u32x4){0u,0u,0u,0u};
  if(MODE==0){ unsigned h2; const unsigned h01=split3(fq_row-Bnd,h2); qaug[0]=hi?(0x3F80u|(h2<<16)):0x3F803F80u; qaug[1]=hi?0u:h01; ka0[1]=hi?0u:0x3F803F80u; ka1[1]=ka0[1]; ka0[0]=fau[0]; ka1[0]=fau[64]; }
  f32x16 cini=f32x16{};
  #define QAUG_MOBA(nb) do{ const float pen_=((smask>>(nb))&1u)?0.f:256.f; const float cv_=-(Bnd+pen_); _Pragma("unroll") for(int r_=0;r_<16;++r_)cini[r_]=cv_; asm volatile("":"+v"(cini)); }while(0)
  if(MODE==1)QAUG_MOBA(0);
  #define KA(x) __builtin_bit_cast(bf16x8,x)
  { const char*kb=Kbase+hi*1024+r32*16;
    if(MODE==0){ pA0=MFMA32(KA(ka0),KA(qaug),f32x16{}); pA1=MFMA32(KA(ka1),KA(qaug),f32x16{}); } else { pA0=cini; pA1=cini; }
    #pragma unroll
    for(int d0=0;d0<4;++d0){ const bf16x8 b0=*reinterpret_cast<const bf16x8*>(kb+d0*2048); const bf16x8 b1=*reinterpret_cast<const bf16x8*>(kb+d0*2048+512);
      pA0=MFMA32(b0,qr[d0],pA0); pA1=MFMA32(b1,qr[d0],pA1); } }
  BANDMASK(pA0,pA1,0);
  _Pragma("unroll") for(int r=0;r<16;++r){pA0[r]=__builtin_amdgcn_exp2f(pA0[r]);pA1[r]=__builtin_amdgcn_exp2f(pA1[r]);}
  WAIT_BAR(0);
  if(tid==0)misc[2]=nxt_;
  DMA_K(3,0);DMA_V(1,SLOTB);
  ROT();
  kload8(kf,kp0+sl_cur);
  if(MODE==0){ ka0[0]=fau[128]; ka1[0]=fau[128+64]; }
  WAIT_BAR(2);
  s16x4 vlo[8],vhi[8]; u32x4 pw0,pw1,pw2,pw3;
  #define PKW(P,B) cvtpk_s(P[B],P[B+1])
  #define PAF(k) __builtin_bit_cast(bf16x8,pw##k)
  #define VFR(i) (bf16x8){vlo[i][0],vlo[i][1],vlo[i][2],vlo[i][3],vhi[i][0],vhi[i][1],vhi[i][2],vhi[i][3]}
  #define PIN(x) asm volatile("":"+v"(x))
  #define GAPA(MF,A0,A1,A2,A3,W0,W1,PW) do{ MF; sacc+=A0; sacc+=A1; sacc+=A2; sacc+=A3; PIN(sacc); W0; W1; PIN(PW); SBAR(); }while(0)
  #define GAP0(MF) do{ MF; SBAR(); }while(0)
  #define EX(v) __builtin_amdgcn_exp2f(v)
  #define GAPB(MF,X,B) do{ MF; X[B]=EX(X[B]); X[B+1]=EX(X[B+1]); X[B+2]=EX(X[B+2]); X[B+3]=EX(X[B+3]); PIN(X); SBAR(); }while(0)
  #define VRD(i) do{ vlo[i]=vtr(vp_+(((i)>>2)*4096+((i)&3)*1024)); vhi[i]=vtr(vp_+(((i)>>2)*4096+((i)&3)*1024+512)); }while(0)
  #define KRD(G,j) do{ if(G){ kload2(kf,kp0+sl_next,j); SBAR(); } }while(0)
  #define KARD(G,t) do{ if(MODE==0&&(G)){ ka0[0]=fau[128*((t)+1)]; ka1[0]=fau[128*((t)+1)+64]; SBAR(); } }while(0)
  #define STEP(C0,C1,P0,P1,t,GK,GV,GL) do{ SBAR(); \
    const lds_cptr vp_=vp0+sl_prev; \
    if(GK){DMA_K((t)+3,sl_cur);} if(GV){DMA_V((t)+1,sl_next);} SBAR(); \
    if(MODE==1&&(((t)&3)==0)){ QAUG_MOBA((t)>>2); SBAR(); } \
    VRD(0); SBAR(); float sacc=(P0[0]+P0[1]); \
    if(MODE==0){ \
    GAPA(C0=MFMA32(KA(ka0),KA(qaug),f32x16{}), P0[2],P0[3],P0[4],P0[5],     pw0[0]=PKW(P0,0), pw0[1]=PKW(P0,2), pw0); \
    VRD(4); SBAR(); GAPA(C1=MFMA32(KA(ka1),KA(qaug),f32x16{}), P0[6],P0[7],P0[8],P0[9],     pw0[2]=PKW(P0,4), pw0[3]=PKW(P0,6), pw0); \
    VRD(1); SBAR(); GAPA(C0=MFMA32(kf[0],qr[0],C0),   P0[10],P0[11],P0[12],P0[13], pw1[0]=PKW(P0,8), pw1[1]=PKW(P0,10), pw1); \
    VRD(5); SBAR(); GAPA(C1=MFMA32(kf[1],qr[0],C1),   P0[14],P0[15],P1[0],P1[1],   pw1[2]=PKW(P0,12),pw1[3]=PKW(P0,14), pw1); \
    GAPA(C0=MFMA32(kf[2],qr[1],C0),   P1[2],P1[3],P1[4],P1[5],     pw2[0]=PKW(P1,0), pw2[1]=PKW(P1,2), pw2); \
    GAPA(C1=MFMA32(kf[3],qr[1],C1),   P1[6],P1[7],P1[8],P1[9],     pw2[2]=PKW(P1,4), pw2[3]=PKW(P1,6), pw2); \
    GAPA(C0=MFMA32(kf[4],qr[2],C0),   P1[10],P1[11],P1[12],P1[13], pw3[0]=PKW(P1,8), pw3[1]=PKW(P1,10), pw3); \
    GAPA(C1=MFMA32(kf[5],qr[2],C1),   P1[14],P1[15],0.f,0.f,       pw3[2]=PKW(P1,12),pw3[3]=PKW(P1,14), pw3); \
    GAP0(C0=MFMA32(kf[6],qr[3],C0)); GAP0(C1=MFMA32(kf[7],qr[3],C1)); \
    } else { \
    GAPA(C0=MFMA32(kf[0],qr[0],cini), P0[2],P0[3],P0[4],P0[5],     pw0[0]=PKW(P0,0), pw0[1]=PKW(P0,2), pw0); \
    VRD(4); SBAR(); GAPA(C1=MFMA32(kf[1],qr[0],cini), P0[6],P0[7],P0[8],P0[9],     pw0[2]=PKW(P0,4), pw0[3]=PKW(P0,6), pw0); \
    VRD(1); SBAR(); GAPA(C0=MFMA32(kf[2],qr[1],C0),   P0[10],P0[11],P0[12],P0[13], pw1[0]=PKW(P0,8), pw1[1]=PKW(P0,10), pw1); \
    VRD(5); SBAR(); GAPA(C1=MFMA32(kf[3],qr[1],C1),   P0[14],P0[15],P1[0],P1[1],   pw1[2]=PKW(P0,12),pw1[3]=PKW(P0,14), pw1); \
    GAPA(C0=MFMA32(kf[4],qr[2],C0),   P1[2],P1[3],P1[4],P1[5],     pw2[0]=PKW(P1,0), pw2[1]=PKW(P1,2), pw2); \
    GAPA(C1=MFMA32(kf[5],qr[2],C1),   P1[6],P1[7],P1[8],P1[9],     pw2[2]=PKW(P1,4), pw2[3]=PKW(P1,6), pw2); \
    GAPA(C0=MFMA32(kf[6],qr[3],C0),   P1[10],P1[11],P1[12],P1[13], pw3[0]=PKW(P1,8), pw3[1]=PKW(P1,10), pw3); \
    GAPA(C1=MFMA32(kf[7],qr[3],C1),   P1[14],P1[15],0.f,0.f,       pw3[2]=PKW(P1,12),pw3[3]=PKW(P1,14), pw3); \
    } \
    l_reg+=sacc; \
    BANDMASK(C0,C1,t); \
    SBAR(); \
    KARD(GL,t); VRD(2); VRD(6); SBAR(); GAPB(o[0]=MFMA32(PAF(0),VFR(0),o[0]), C0,0); \
    VRD(3); VRD(7); SBAR(); GAPB(o[1]=MFMA32(PAF(0),VFR(4),o[1]), C0,4); \
    KRD(GL,0); GAPB(o[0]=MFMA32(PAF(1),VFR(1),o[0]), C0,8); \
    KRD(GL,1); GAPB(o[1]=MFMA32(PAF(1),VFR(5),o[1]), C0,12); \
    KRD(GL,2); GAPB(o[0]=MFMA32(PAF(2),VFR(2),o[0]), C1,0); \
    KRD(GL,3); GAPB(o[1]=MFMA32(PAF(2),VFR(6),o[1]), C1,4); \
    GAPB(o[0]=MFMA32(PAF(3),VFR(3),o[0]), C1,8); \
    GAPB(o[1]=MFMA32(PAF(3),VFR(7),o[1]), C1,12); \
    }while(0)
  int t=1;
  #undef BANDMASK
  #define BANDMASK(P0,P1,t) do{}while(0)
  for(;t+7<NT;t+=2){
    STEP(pB0,pB1,pA0,pA1,t,true,true,true);     WAIT_BAR(2); ROT();
    STEP(pA0,pA1,pB0,pB1,t+1,true,true,true);   WAIT_BAR(2); ROT();
  }
  #undef BANDMASK
  #define BANDMASK(P0,P1,t) do{int jb_=(t)-(NT-4); if(MODE==1&&jb_>=-2&&(32*wid-64*jb_<176))bias_add(P0,P1,jb_,qrel,hi,tabp); if(jb_>=(wid>>1))cmask(P0,P1,jb_,qrel,hi); }while(0)
  #define ENDW(tt) do{ if((tt)+3<NT){WAIT_BAR(2);} else if((tt)+2<NT){WAIT_BAR(1);} else {WAIT_BAR(0);} }while(0)
  for(;t+3<NT;t+=2){
    STEP(pB0,pB1,pA0,pA1,t,(t+3<NT),(t+1<NT),(t+1<NT));       ENDW(t);   ROT();
    STEP(pA0,pA1,pB0,pB1,t+1,(t+4<NT),(t+2<NT),(t+2<NT));     ENDW(t+1); ROT();
  }
  #define STEP_PV(P0,P1,t,GK,GV) do{ SBAR(); const lds_cptr vp_=vp0+sl_prev; if(GK){DMA_K((t)+3,sl_cur);} if(GV){DMA_V((t)+1,sl_next);} SBAR(); \
    VRD(0);VRD(4);VRD(1);VRD(5); \
    { float sacc=P0[0]+P0[1]; _Pragma("unroll") for(int r_=2;r_<16;++r_)sacc+=P0[r_]; _Pragma("unroll") for(int r_=0;r_<16;++r_)sacc+=P1[r_]; l_reg+=sacc; } \
    pw0=(u32x4){PKW(P0,0),PKW(P0,2),PKW(P0,4),PKW(P0,6)};pw1=(u32x4){PKW(P0,8),PKW(P0,10),PKW(P0,12),PKW(P0,14)};pw2=(u32x4){PKW(P1,0),PKW(P1,2),PKW(P1,4),PKW(P1,6)};pw3=(u32x4){PKW(P1,8),PKW(P1,10),PKW(P1,12),PKW(P1,14)}; SBAR(); \
    VRD(2);VRD(6);VRD(3);VRD(7); \
    o[0]=MFMA32(PAF(0),VFR(0),o[0]); o[1]=MFMA32(PAF(0),VFR(4),o[1]); o[0]=MFMA32(PAF(1),VFR(1),o[0]); o[1]=MFMA32(PAF(1),VFR(5),o[1]); \
    o[0]=MFMA32(PAF(2),VFR(2),o[0]); o[1]=MFMA32(PAF(2),VFR(6),o[1]); o[0]=MFMA32(PAF(3),VFR(3),o[0]); o[1]=MFMA32(PAF(3),VFR(7),o[1]); SBAR(); }while(0)
  STEP(pB0,pB1,pA0,pA1,t,(t+3<NT),(t+1<NT),(t+1<NT));       ENDW(t);   ROT();
  const int nx_=__builtin_amdgcn_readfirstlane((int)misc[2]); const bool pre_next=nx_<128;
  if(SKIP_MODES(MODE)&&wid<4){
  STEP_PV(pB0,pB1,t+1,false,true); ENDW(t+1); ROT();
  if(pre_next){ const int qb2=15-(nx_>>3),h2=nx_&7; int T2=0; if(MODE==0)T2=__builtin_amdgcn_readfirstlane(((const __attribute__((address_space(3))) int*)(shm3+LDS_TAB))[h2*16+qb2]);
    const bf16*ks2=QKV+(rowbase+(long)(T2*KVBLK+lane))*QP+(MODE?1536:0)+h2*D+512+wid*8;
    glds16(ks2,(unsigned)__builtin_amdgcn_readfirstlane(kdst)); glds16(ks2+(long)KVBLK*QP,(unsigned)__builtin_amdgcn_readfirstlane(kdst+SLOTB)); glds16(ks2+(long)2*KVBLK*QP,(unsigned)__builtin_amdgcn_readfirstlane(kdst+2*SLOTB));
    if(MODE==0){ const int NT2=4*(qb2+1)-T2; const char*src2=(const char*)(Kaug+(size_t)(b*NHEAD+h2)*SEQ+KVBLK*T2)+lane*16;
      for(int pc=wid;pc<NT2/2;pc+=NW)glds16(src2+pc*1024,(unsigned)__builtin_amdgcn_readfirstlane(lds0+LDS_FAUG+KVBLK*T2*8+pc*1024)); } }
  }else{
  STEP(pA0,pA1,pB0,pB1,t+1,false,true,true); ENDW(t+1); ROT();
  if(pre_next){ const int qb2=15-(nx_>>3),h2=nx_&7; int T2=0; if(MODE==0)T2=__builtin_amdgcn_readfirstlane(((const __attribute__((address_space(3))) int*)(shm3+LDS_TAB))[h2*16+qb2]);
    const bf16*ks2=QKV+(rowbase+(long)(T2*KVBLK+lane))*QP+(MODE?1536:0)+h2*D+512+wid*8;
    glds16(ks2,(unsigned)__builtin_amdgcn_readfirstlane(kdst)); glds16(ks2+(long)KVBLK*QP,(unsigned)__builtin_amdgcn_readfirstlane(kdst+SLOTB)); glds16(ks2+(long)2*KVBLK*QP,(unsigned)__builtin_amdgcn_readfirstlane(kdst+2*SLOTB));
    if(MODE==0){ const int NT2=4*(qb2+1)-T2; const char*src2=(const char*)(Kaug+(size_t)(b*NHEAD+h2)*SEQ+KVBLK*T2)+lane*16;
      for(int pc=wid;pc<NT2/2;pc+=NW)glds16(src2+pc*1024,(unsigned)__builtin_amdgcn_readfirstlane(lds0+LDS_FAUG+KVBLK*T2*8+pc*1024)); } }
  STEP(pB0,pB1,pA0,pA1,NT-1,false,false,false);
  { float sacc=pB0[0]+pB0[1]; _Pragma("unroll") for(int r=2;r<16;++r)sacc+=pB0[r]; _Pragma("unroll") for(int r=0;r<16;++r)sacc+=pB1[r]; l_reg+=sacc;
    pw0=(u32x4){PKW(pB0,0),PKW(pB0,2),PKW(pB0,4),PKW(pB0,6)};pw1=(u32x4){PKW(pB0,8),PKW(pB0,10),PKW(pB0,12),PKW(pB0,14)};pw2=(u32x4){PKW(pB1,0),PKW(pB1,2),PKW(pB1,4),PKW(pB1,6)};pw3=(u32x4){PKW(pB1,8),PKW(pB1,10),PKW(pB1,12),PKW(pB1,14)};
    SBAR(); pv(o,vb0+sl_cur,PAF(0),PAF(1),PAF(2),PAF(3)); }
  }
  int tid_t=threadIdx.x; asm volatile("":"+v"(tid_t)); const int lane_t=tid_t&63,r32_t=lane_t&31,hi_t=lane_t>>5;
  int qb2_=0,h2_=0,T2_=0;
  _Pragma("unroll") for(int d0=0;d0<4;++d0)sm.q[d0]=(bf16x8){0,0,0,0,0,0,0,0}; sm.tabv=0.f; sm.km0=0.f; sm.km1=0.f; sm.r0=0.f; sm.r31=0.f; sm.fq=0.f; sm.base=basev;
  if(pre_next){ qb2_=15-(nx_>>3); h2_=nx_&7; if(MODE==0)T2_=__builtin_amdgcn_readfirstlane(((const __attribute__((address_space(3))) int*)(shm3+LDS_TAB))[h2_*16+qb2_]);
    const bf16*Qw2=QKV+(rowbase+(long)(qb2_*QB+wid*QBLK))*QP+(MODE?1536:0)+h2_*D;
    #pragma unroll
    for(int d0=0;d0<4;++d0)sm.q[d0]=__builtin_nontemporal_load(reinterpret_cast<const bf16x8*>(&Qw2[(long)r32_t*QP+d0*16+hi_t*8]));
    if(MODE==0){ sm.fq=Fl2[(size_t)(b*NHEAD+h2_)*SEQ+qb2_*QB+wid*QBLK+r32_t]; }
    else { const int bh2=b*NHEAD+h2_; sm.tabv=0.f; sm.r0=lane_t<32?relb[lane_t*8+h2_]:0.f; sm.r31=relb[31*8+h2_]; if(tid_t<113)sm.tabv=(relb[t5b[tid_t]*8+h2_]-relb[31*8+h2_])*1.4426950408889634f;
      const float*p0=kmp+((size_t)((bh2*16+(tid_t>>6))*2))*64+(tid_t&63); const float*p1=kmp+((size_t)((bh2*16+8+(tid_t>>6))*2))*64+(tid_t&63); sm.km0=p0[0]+p0[64]; sm.km1=p1[0]+p1[64]; } }
  #undef PKW
  #undef PAF
  #undef VFR
  #undef PIN
  #undef GAPA
  #undef GAP0
  #undef GAPB
  #undef EX
  #undef VRD
  #undef KRD
  #undef KARD
  #undef STEP
  #undef STEP_PV
  #undef ENDW
  #undef KA
  #undef QAUG_MOBA
  {auto rr=__builtin_amdgcn_permlane32_swap(__float_as_uint(l_reg),__float_as_uint(l_reg),false,false);l_reg=__uint_as_float(rr[0])+__uint_as_float(rr[1]);}
  if(hi_t==0)wsf[32+r32_t]=l_reg;asm volatile("s_waitcnt lgkmcnt(0)":::"memory");
  float rli[16];
  #pragma unroll
  for(int r=0;r<16;++r)rli[r]=__builtin_amdgcn_rcpf(wsf[32+crow(r,hi_t)]);
  bf16*Ow=O+(rowbase+q0+wid*QBLK)*OP+MODE*512+h*D;
  { bf16*stg=(bf16*)(shm+LDS_OST)+wid*2048;
    #pragma unroll
    for(int r=0;r<16;++r){const int orow=crow(r,hi_t);
      #pragma unroll
      for(int d0=0;d0<2;++d0)stg[orow*64+d0*32+r32_t]=__float2bfloat16(o[d0][r]*rli[r]);}
    asm volatile("s_waitcnt lgkmcnt(0)":::"memory");
    #pragma unroll
    for(int i=0;i<4;++i){const int row=i*8+(lane_t>>3),ch=lane_t&7; const u32x4 v=*(const u32x4*)(stg+row*64+ch*8); *(u32x4*)(Ow+(long)row*OP+ch*8)=v;} }
  if(tid_t==0)misc[0]=nxt_;
  asm volatile("s_waitcnt lgkmcnt(0)\n\ts_barrier":::"memory");
  const int next_unit=(int)misc[0];
  #undef DMA_K
  #undef DMA_V
  #undef BANDMASK
  #undef ROT
  return next_unit;
}
constexpr int ATTN_LDS_BYTES=LDS_BYTES;
#undef SBAR
#undef WAIT_BAR
#undef MFMA32
}

#define LAS __attribute__((address_space(3)))
typedef unsigned short bf16_t;
constexpr int NWAVES = 8, NTHREADS = 512;
constexpr int RING_BYTES = 131072, EXT_OFF = RING_BYTES + 256, LDS_BYTES = 150528;
#define LDS_WAIT() asm volatile("s_waitcnt lgkmcnt(0)" ::: "memory")
#ifndef P0B_W16
#define P0B_W16 1
#endif
#ifdef NT_P0
#define LDW(p) __builtin_nontemporal_load((const float*)(p))
#else
#define LDW(p) (*(const float*)(p))
#endif
#ifdef NT_X
#define LDX(p) __builtin_nontemporal_load((const f32x4*)(p))
#else
#define LDX(p) (*(const f32x4*)(p))
#endif

struct Params { const float* in[17]; float* out; unsigned char* ws; };

#define XB_TMO      128
#define XB_XCNT(j)  (256  + 64 * (j))
#define XB_XSUB(j)  (1280 + 64 * (j))
#define XB_XGEN(j)  (2304 + 64 * (j))
#define XB_TOP      3328
#define XB_TOPGEN   3392
#define XCD_BAR_WORDS 3456
#define XB_SPIN_CAP (1u << 18)

__device__ __forceinline__ unsigned xb_ld(unsigned* p)              { return __hip_atomic_load(p, __ATOMIC_RELAXED, __HIP_MEMORY_SCOPE_AGENT); }
__device__ __forceinline__ unsigned xb_add(unsigned* p, unsigned v) { return __hip_atomic_fetch_add(p, v, __ATOMIC_RELAXED, __HIP_MEMORY_SCOPE_AGENT); }
__device__ __forceinline__ unsigned xb_xcc_id() { return (unsigned)__builtin_amdgcn_s_getreg((3 << 11) | 20) & 0xFu; }
#define XB_SPIN(cond, bar) do { unsigned _sp = 0; while (cond) { __builtin_amdgcn_s_sleep(1); \
    if ((++_sp & 255u) == 0u) { if (xb_ld(&(bar)[XB_TMO])) break; if (_sp > XB_SPIN_CAP) { atomicAdd(&(bar)[XB_TMO], 1u); break; } } } } while (0)

struct XcdBarrier {
    unsigned* bar; unsigned x;
    volatile LAS unsigned* st;
};

__device__ __forceinline__ XcdBarrier xcd_barrier_post(unsigned* bar, volatile LAS unsigned* st) {
    XcdBarrier b; b.bar = bar; b.x = xb_xcc_id(); b.st = st;
    if (threadIdx.x == 0) (void)xb_add(&bar[XB_XCNT(b.x)], 1u);
    return b;
}
__device__ __forceinline__ void xcd_barrier_complete(unsigned* bar, unsigned x, unsigned& nloc, unsigned& nx) {
    const unsigned G = gridDim.x * gridDim.y * gridDim.z;
    unsigned sum, cnt, mine, sp = 0u;
    for (;;) {
        sum = 0u; cnt = 0u; mine = 0u;
#pragma unroll
        for (unsigned j = 0; j < 16; ++j) { const unsigned c = xb_ld(&bar[XB_XCNT(j)]); sum += c; cnt += (c > 0u) ? 1u : 0u; mine = (j == x) ? c : mine; }
        if (sum == G) break;
        __builtin_amdgcn_s_sleep(1);
        if ((++sp & 255u) == 0u) { if (xb_ld(&bar[XB_TMO])) break; if (sp > XB_SPIN_CAP) { atomicAdd(&bar[XB_TMO], 1u); break; } }
    }
    nloc = mine > 0u ? mine : 1u; nx = cnt > 0u ? cnt : 1u;
}

__device__ __forceinline__ void xcd_barrier(const XcdBarrier& b) {
    asm volatile("s_waitcnt vmcnt(0)" ::: "memory");
    __syncthreads();
    if (threadIdx.x == 0) {
        unsigned* bar = b.bar;
        __builtin_amdgcn_s_waitcnt(0);
        unsigned nloc = b.st[0], nx = b.st[1];
        if (nloc == 0u) { xcd_barrier_complete(bar, b.x, nloc, nx); b.st[0] = nloc; b.st[1] = nx; }
        const unsigned old = xb_add(&bar[XB_XSUB(b.x)], 1u);
        const unsigned gen = old / nloc;
        if (old + 1u == (gen + 1u) * nloc) {
            __builtin_amdgcn_fence(__ATOMIC_RELEASE, "agent");
            asm volatile("s_waitcnt vmcnt(0)" ::: "memory");
            const unsigned og = xb_add(&bar[XB_TOP], 1u);
            const unsigned tg = og / nx;
            if (og + 1u == (tg + 1u) * nx) xb_add(&bar[XB_TOPGEN], 1u);
            else XB_SPIN(xb_ld(&bar[XB_TOPGEN]) == tg, bar);
            __builtin_amdgcn_fence(__ATOMIC_ACQUIRE, "agent");
            xb_add(&bar[XB_XGEN(b.x)], 1u);
            asm volatile("s_waitcnt vmcnt(0)" ::: "memory");
        } else {
            XB_SPIN(xb_ld(&bar[XB_XGEN(b.x)]) == gen, bar);
            __builtin_amdgcn_fence(__ATOMIC_ACQUIRE, "agent");
            asm volatile("s_waitcnt vmcnt(0)" ::: "memory");
        }
    }
    __syncthreads();
}


__device__ __forceinline__ void tr_item(const float* __restrict__ W, int Nsrc, int K, int k0, int nsrc0, bf16_t* __restrict__ WT, int nout0, LAS float* scr, int lane) {
    float wv_[32];
#pragma unroll
    for (int i = 0; i < 32; ++i) wv_[i] = LDW(W + (size_t)(k0 + 2 * i + (lane >> 5)) * Nsrc + nsrc0 + (lane & 31));
#pragma unroll
    for (int i = 0; i < 32; ++i) scr[(2 * i + (lane >> 5)) * 33 + (lane & 31)] = wv_[i];
    LDS_WAIT(); asm volatile("" ::: "memory");
    const int c = lane & 7;
#pragma unroll
    for (int j = 0; j < 4; ++j) { const int n = (lane >> 3) + 8 * j; const LAS float* s = scr + (8 * c) * 33 + n;
        u32x4 o; o.x = pk2(s[0 * 33], s[1 * 33]); o.y = pk2(s[2 * 33], s[3 * 33]); o.z = pk2(s[4 * 33], s[5 * 33]); o.w = pk2(s[6 * 33], s[7 * 33]);
        *(u32x4*)(WT + (size_t)(nout0 + n) * K + k0 + 8 * c) = o; }
    LDS_WAIT(); asm volatile("" ::: "memory");
}
__device__ __forceinline__ void p0_weights(const Params& p, LAS unsigned char* lds, int gw, int ngw, int wave, int lane) {
    LAS float* scr = (LAS float*)(lds + wave * 16384);
    bf16_t* Wt_in = (bf16_t*)(p.ws + WS_WIN); bf16_t* Wt_o = (bf16_t*)(p.ws + WS_WO); bf16_t* Wt_gu = (bf16_t*)(p.ws + WS_WGU); bf16_t* Wt_dn = (bf16_t*)(p.ws + WS_WDN);
    constexpr int I_IN = 16 * 96, I_O = 16 * 32, I_GU = 16 * 176, I_DN = 44 * 32, NIT = I_IN + I_O + I_GU + I_DN;
    for (int it = gw; it < NIT; it += ngw) {
        int r = it;
        if (r < I_IN) { const int kb = r / 96, nb = r % 96, L0 = 32 * nb, pn = L0 >> 8, bj = (L0 >> 7) & 1, wc = (L0 >> 5) & 3, sec = pn >> 1, head = 4 * (pn & 1) + wc;
            const int src = 512 * sec + (sec >= 3 ? 8 : 0) + 64 * head + 32 * bj;
            tr_item(p.in[6], INC, DM, 64 * kb, src, Wt_in, L0, scr, lane); continue; }
        r -= I_IN;
        if (r < I_O) { const int kb = r / 32, nb = r % 32; tr_item(p.in[13], DM, DM, 64 * kb, 32 * nb, Wt_o, 32 * nb, scr, lane); continue; }
        r -= I_O;
        if (r < I_GU) { const int kb = r / 176, nb = r % 176, L0 = 32 * nb, pn = L0 >> 8, bj = (L0 >> 7) & 1, j0 = L0 & 127;
            tr_item(bj ? p.in[15] : p.in[14], DFF, DM, 64 * kb, 128 * pn + j0, Wt_gu, L0, scr, lane); continue; }
        r -= I_GU;
        { const int kb = r / 32, nb = r % 32; tr_item(p.in[16], DM, DFF, 64 * kb, 32 * nb, Wt_dn, 32 * nb, scr, lane); }
    }
}
__device__ __forceinline__ void p0_mod(const Params& p, LAS unsigned char* lds, int tid, int wave, int lane) {
    LAS float* sc = (LAS float*)lds; LAS float* red = (LAS float*)(lds + 32768);
    const float* c = p.in[1]; const float* w_ada = p.in[2]; const float* b_ada = p.in[3]; float* mod = (float*)(p.ws + WS_MOD);
    for (int i = tid; i < 8192; i += NTHREADS) { const float v = c[i]; sc[i] = v / (1.f + expf(-v)); }
    __syncthreads();
    const int col = blockIdx.x * 64 + lane;
    float a0 = 0, a1 = 0, a2 = 0, a3 = 0, a4 = 0, a5 = 0, a6 = 0, a7 = 0;
#pragma unroll 1
    for (int kb = wave * 128; kb < wave * 128 + 128; kb += 16) {
        float wv_[16];
#pragma unroll
        for (int i = 0; i < 16; ++i) wv_[i] = LDW(w_ada + (size_t)(kb + i) * 6144 + col);
#pragma unroll
        for (int i = 0; i < 16; ++i) { const float w = wv_[i]; const int k = kb + i;
            a0 += sc[k] * w; a1 += sc[1024 + k] * w; a2 += sc[2048 + k] * w; a3 += sc[3072 + k] * w;
            a4 += sc[4096 + k] * w; a5 += sc[5120 + k] * w; a6 += sc[6144 + k] * w; a7 += sc[7168 + k] * w;
            if ((i & 3) == 3) asm volatile("" ::: "memory"); }
    }
    LAS float* rw = red + wave * 512 + lane;
    rw[0] = a0; rw[64] = a1; rw[128] = a2; rw[192] = a3; rw[256] = a4; rw[320] = a5; rw[384] = a6; rw[448] = a7;
    __syncthreads();
    { const int b = tid >> 6; float s = 0.f;
#pragma unroll
      for (int w = 0; w < 8; ++w) s += red[w * 512 + b * 64 + lane];
      mod[b * 6144 + col] = s + b_ada[col]; }
    __syncthreads();
}
__device__ __forceinline__ float red8(const float (&ff)[8], int lane) {
    const bool b0 = (lane & 1) != 0, b1 = (lane & 2) != 0, b2 = (lane & 4) != 0;
    float t[4], u[2];
#pragma unroll
    for (int k = 0; k < 4; ++k) { const float a = b0 ? ff[2 * k + 1] : ff[2 * k], o = b0 ? ff[2 * k] : ff[2 * k + 1]; t[k] = a + lx1(o); }
#pragma unroll
    for (int k = 0; k < 2; ++k) { const float a = b1 ? t[2 * k + 1] : t[2 * k], o = b1 ? t[2 * k] : t[2 * k + 1]; u[k] = a + lx2(o); }
    float w = (b2 ? u[1] : u[0]) + lx4(b2 ? u[0] : u[1], b2);
    w += lx8(w); w = addx16(w); w = addx32(w);
    return w;
}
#if P0B_W16
#define KIDX(j) (512 * ((j) >> 1) + 8 * lane + 4 * ((j) & 1))
#else
#define KIDX(j) (256 * (j) + 4 * lane)
#endif
__device__ __forceinline__ void p0b_rows(const Params& p, LAS unsigned char* lds, int tid, int gw, int ngw, int lane) {
    const float* x = p.in[0]; const float* mod = (const float*)(p.ws + WS_MOD); const float* gain = p.in[4]; const float* w_in = p.in[6]; const float* b_forget = p.in[7];
    bf16_t* XN = (bf16_t*)(p.ws + WS_XN); float* logf = (float*)(p.ws + WS_LOGF);
    LAS float* wf = (LAS float*)lds;
    for (int i = tid; i < 8192; i += NTHREADS) { const int k = i >> 3, h = i & 7; wf[h * 1024 + k] = w_in[(size_t)k * INC + 1536 + h]; }
    __syncthreads();
    const float bfv = b_forget[lane & 7];
    const int RPW = MROWS / ngw;
#pragma unroll 1
    for (int rbase = gw * RPW; rbase < MROWS; rbase += ngw * RPW) {
        const int b = rbase >> 12;
        const float* shift = mod + b * 6144; const float* scale = shift + 1024;
        f32x4 gs[4], sh[4];
#pragma unroll
        for (int j = 0; j < 4; ++j) { const int k = KIDX(j); gs[j] = *(const f32x4*)(gain + k) * (*(const f32x4*)(scale + k) + 1.0f); sh[j] = *(const f32x4*)(shift + k); }
        asm volatile("" ::: "memory");
        f32x4 c0[4], c1[4], n0[4], n1[4];
#pragma unroll
        for (int j = 0; j < 4; ++j) { c0[j] = LDX(x + (size_t)rbase * DM + KIDX(j)); c1[j] = LDX(x + (size_t)(rbase + 1) * DM + KIDX(j)); }
#pragma unroll 1
        for (int i = 0; i < RPW; i += 2) {
            const int r0 = rbase + i, r1 = r0 + 1;
            if (i + 2 < RPW) {
#pragma unroll
                for (int j = 0; j < 4; ++j) { n0[j] = LDX(x + (size_t)(r0 + 2) * DM + KIDX(j)); n1[j] = LDX(x + (size_t)(r0 + 3) * DM + KIDX(j)); }
            }
            typedef float f32x2s_ __attribute__((ext_vector_type(2)));
            f32x2s_ q0a = {0.f, 0.f}, q0b = {0.f, 0.f}, q1a = {0.f, 0.f}, q1b = {0.f, 0.f};
#pragma unroll
            for (int j = 0; j < 4; ++j) { const f32x2s_ a0 = {c0[j][0], c0[j][1]}, b0 = {c0[j][2], c0[j][3]}, a1 = {c1[j][0], c1[j][1]}, b1 = {c1[j][2], c1[j][3]};
                q0a = __builtin_elementwise_fma(a0, a0, q0a); q0b = __builtin_elementwise_fma(b0, b0, q0b); q1a = __builtin_elementwise_fma(a1, a1, q1a); q1b = __builtin_elementwise_fma(b1, b1, q1b); }
            float s0 = (q0a.x + q0a.y) + (q0b.x + q0b.y), s1 = (q1a.x + q1a.y) + (q1b.x + q1b.y);
            s0 = wave_sum(s0); s1 = wave_sum(s1);
            const float rs0 = __builtin_amdgcn_rsqf(s0 * (1.0f / DM) + EPS), rs1 = __builtin_amdgcn_rsqf(s1 * (1.0f / DM) + EPS);
            typedef float f32x2_ __attribute__((ext_vector_type(2)));
            f32x2_ g0[8], g1[8]; u32x2 wp0 = {0u, 0u}, wp1 = {0u, 0u};
#pragma unroll
            for (int hh = 0; hh < 8; ++hh) { g0[hh] = (f32x2_){0.f, 0.f}; g1[hh] = (f32x2_){0.f, 0.f}; }
#pragma unroll
            for (int j = 0; j < 4; ++j) {
                const int k = KIDX(j);
                const f32x4 h0 = (c0[j] * rs0) * gs[j] + sh[j], h1 = (c1[j] * rs1) * gs[j] + sh[j];
                u32x2 w0, w1; w0.x = pg8::cvt_pk_bf16(h0[0], h0[1]); w0.y = pg8::cvt_pk_bf16(h0[2], h0[3]); w1.x = pg8::cvt_pk_bf16(h1[0], h1[1]); w1.y = pg8::cvt_pk_bf16(h1[2], h1[3]);
#if P0B_W16
                if (j & 1) { u32x4 q0, q1; q0.x = wp0.x; q0.y = wp0.y; q0.z = w0.x; q0.w = w0.y; q1.x = wp1.x; q1.y = wp1.y; q1.z = w1.x; q1.w = w1.y;
                    *(u32x4*)(XN + (size_t)r0 * DM + k - 4) = q0; *(u32x4*)(XN + (size_t)r1 * DM + k - 4) = q1; }
                else { wp0 = w0; wp1 = w1; }
#else
                *(u32x2*)(XN + (size_t)r0 * DM + k) = w0; *(u32x2*)(XN + (size_t)r1 * DM + k) = w1;
#endif
                f32x4 wv[8];
#pragma unroll
                for (int hh = 0; hh < 8; ++hh) wv[hh] = *(const LAS f32x4*)(wf + hh * 1024 + k);
                asm volatile("" ::: "memory");
#pragma unroll
                for (int hh = 0; hh < 8; ++hh) { const f32x2_ wa = {wv[hh][0], wv[hh][1]}, wb = {wv[hh][2], wv[hh][3]};
                    g0[hh] = __builtin_elementwise_fma((f32x2_){h0[0], h0[1]}, wa, g0[hh]); g1[hh] = __builtin_elementwise_fma((f32x2_){h1[0], h1[1]}, wa, g1[hh]);
                    g0[hh] = __builtin_elementwise_fma((f32x2_){h0[2], h0[3]}, wb, g0[hh]); g1[hh] = __builtin_elementwise_fma((f32x2_){h1[2], h1[3]}, wb, g1[hh]); }
            }
            float f0[8], f1[8];
#pragma unroll
            for (int hh = 0; hh < 8; ++hh) { f0[hh] = g0[hh].x + g0[hh].y; f1[hh] = g1[hh].x + g1[hh].y; }
            const float z0 = red8(f0, lane) + bfv, z1 = red8(f1, lane) + bfv;
            if (lane < 8) {
                float* lf = logf + ((size_t)(b * 8 + lane)) * SEQ + (r0 & 4095);
                lf[0] = fminf(z0, 0.f) - log1pf(expf(-fabsf(z0)));
                lf[1] = fminf(z1, 0.f) - log1pf(expf(-fabsf(z1)));
            }
#pragma unroll
            for (int j = 0; j < 4; ++j) { c0[j] = n0[j]; c1[j] = n1[j]; }
        }
    }
}
#undef KIDX
__device__ __forceinline__ void p0b_c2(const Params& p, LAS unsigned char* lds, int tid, int gw, int ngw, int lane) {
    const float* mod = (const float*)(p.ws + WS_MOD); const bf16_t* Wgu = (const bf16_t*)(p.ws + WS_WGU); float* c2 = (float*)(p.ws + WS_C2);
    LAS float* s2 = (LAS float*)(lds + 32768);
    for (int i = tid; i < 8192; i += NTHREADS) s2[i] = mod[(i >> 10) * 6144 + 3 * 1024 + (i & 1023)];
    __syncthreads();
#pragma unroll 1
    for (int n = gw; n < NGU; n += ngw) {
        const u32x4 w0 = *(const u32x4*)(Wgu + (size_t)n * DM + 16 * lane), w1 = *(const u32x4*)(Wgu + (size_t)n * DM + 16 * lane + 8);
        const float wv[16] = {bf2f(w0.x & 0xffffu), bf2f(w0.x >> 16), bf2f(w0.y & 0xffffu), bf2f(w0.y >> 16), bf2f(w0.z & 0xffffu), bf2f(w0.z >> 16), bf2f(w0.w & 0xffffu), bf2f(w0.w >> 16),
                              bf2f(w1.x & 0xffffu), bf2f(w1.x >> 16), bf2f(w1.y & 0xffffu), bf2f(w1.y >> 16), bf2f(w1.z & 0xffffu), bf2f(w1.z >> 16), bf2f(w1.w & 0xffffu), bf2f(w1.w >> 16)};
        float a[8];
#pragma unroll
        for (int b = 0; b < 8; ++b) {
            const LAS float* sh = s2 + b * 1024 + 16 * lane; float t = 0.f;
#pragma unroll
            for (int q4 = 0; q4 < 4; ++q4) { const f32x4 s4 = *(const LAS f32x4*)(sh + 4 * q4); t += (s4[0] * wv[4 * q4] + s4[1] * wv[4 * q4 + 1]) + (s4[2] * wv[4 * q4 + 2] + s4[3] * wv[4 * q4 + 3]); }
            a[b] = t;
        }
        const float r = red8(a, lane);
        if (lane < 8) c2[lane * NGU + n] = r;
    }
}
#ifndef FOX_SKIP_BITS
#define FOX_SKIP_BITS 40
#endif
__device__ __forceinline__ void p1_scan(const Params& p, LAS unsigned char* lds, int tid) {
    LAS double* part = (LAS double*)lds;
    const float* src = (const float*)(p.ws + WS_LOGF) + (size_t)blockIdx.x * SEQ + tid * 8;
    double run = 0.0; double loc[8];
#pragma unroll
    for (int i = 0; i < 8; ++i) { run += (double)src[i]; loc[i] = run; }
    double inc = run;
#pragma unroll
    for (int o = 1; o < 64; o <<= 1) { const double up = __shfl_up(inc, o); if ((tid & 63) >= o) inc += up; }
    if ((tid & 63) == 63) part[tid >> 6] = inc;
    __syncthreads();
    double off = inc - run;
    for (int w = 0; w < (tid >> 6); ++w) off += part[w];
    float* dst = (float*)(p.ws + WS_FL2) + (size_t)blockIdx.x * SEQ + tid * 8;
    u32x2* ka = (u32x2*)(p.ws + WS_KAUG) + (size_t)blockIdx.x * SEQ + tid * 8;
#pragma unroll
    for (int i = 0; i < 8; ++i) {
        const double v = -(off + loc[i]) * 1.4426950408889634;
        dst[i] = (float)(-v);
        const unsigned h0 = f2bf((float)v); const double r1 = v - (double)bf2f(h0);
        const unsigned h1 = f2bf((float)r1); const double r2 = r1 - (double)bf2f(h1);
        const unsigned h2 = f2bf((float)r2);
        u32x2 w; w.x = h0 | (h1 << 16); w.y = h2 | 0x3F800000u; ka[i] = w;
    }
    float thr = 152.0f;
    if (tid < 64) { const float* gt = (const float*)(p.ws + WS_GT); const float gq = fabsf(gt[tid]), gk = fabsf(gt[64 + tid]);
        const float Bq = 64.f * attn_body::wmax(gq) * attn_body::wmax(gk) * (0.125f * 1.4426950408889634f) * 1.02f + 0.25f; thr = fminf(152.0f, 2.0f * Bq + (float)FOX_SKIP_BITS); }
    __syncthreads();
    LAS float* tend = (LAS float*)(lds + 8192); LAS float* fq0 = tend + 64;
    if ((tid & 7) == 7) tend[tid >> 3] = (float)((off + loc[7]) * 1.4426950408889634);
    if ((tid & 31) == 0) fq0[tid >> 5] = (float)((off + loc[0]) * 1.4426950408889634);
    __syncthreads();
    if (tid < 16) { int cnt = 0; const float f0 = fq0[tid]; for (int t = 0; t < 4 * tid; ++t) cnt += (tend[t] - f0 > thr) ? 1 : 0; ((int*)(p.ws + WS_T0))[blockIdx.x * 16 + tid] = cnt & ~1; }
    __syncthreads();
}

#ifndef REP_P0
#define REP_P0 1
#endif
#ifndef REP_P0B
#define REP_P0B 1
#endif
#ifndef REP_P1
#define REP_P1 1
#endif
#ifndef REP_P2
#define REP_P2 1
#endif
#ifndef REP_P3
#define REP_P3 1
#endif
#ifndef REP_P4
#define REP_P4 1
#endif
constexpr int CTL_MODCNT = 3584, CTL_SCANCNT = 3648;
__device__ __forceinline__ void flag_arrive(unsigned* cnt) {
    asm volatile("s_waitcnt vmcnt(0)" ::: "memory");
    __syncthreads();
    if (threadIdx.x == 0) { __builtin_amdgcn_fence(__ATOMIC_RELEASE, "agent"); asm volatile("s_waitcnt vmcnt(0)" ::: "memory"); (void)xb_add(cnt, 1u); }
}
__device__ __forceinline__ void flag_wait(unsigned* cnt, unsigned need, unsigned* bar) {
    if (threadIdx.x == 0) { XB_SPIN(xb_ld(cnt) < need, bar); __builtin_amdgcn_fence(__ATOMIC_ACQUIRE, "agent"); asm volatile("s_waitcnt vmcnt(0)" ::: "memory"); }
    __syncthreads();
}
__global__ void __launch_bounds__(NTHREADS, 2) mega_fwd(Params p) {
    extern __shared__ __attribute__((aligned(16))) unsigned char lds[];
    LAS unsigned char* L = (LAS unsigned char*)lds;
    const int tid = threadIdx.x, lane = tid & 63, wave = __builtin_amdgcn_readfirstlane(tid >> 6);
    const int G = gridDim.x, gw = blockIdx.x * NWAVES + wave, ngw = G * NWAVES;
    unsigned char* ws = p.ws;
    volatile LAS unsigned* MISC = (volatile LAS unsigned*)(L + RING_BYTES);
    if (tid < 16) MISC[tid] = 0u;
    __syncthreads();
    XcdBarrier xbar = xcd_barrier_post((unsigned*)(ws + WS_CTL), MISC + 8);
#define GRID_BAR() xcd_barrier(xbar)
    const bf16_t* Wt_in = (const bf16_t*)(ws + WS_WIN); const bf16_t* Wt_o = (const bf16_t*)(ws + WS_WO); const bf16_t* Wt_gu = (const bf16_t*)(ws + WS_WGU); const bf16_t* Wt_dn = (const bf16_t*)(ws + WS_WDN);
    bf16_t* XN = (bf16_t*)(ws + WS_XN); bf16_t* QKV = (bf16_t*)(ws + WS_QKV); bf16_t* Hb = (bf16_t*)(ws + WS_H); bf16_t* ATT = (bf16_t*)(ws + WS_ATT);
    float* mod = (float*)(ws + WS_MOD); float* c2 = (float*)(ws + WS_C2); float* kmp = (float*)(ws + WS_KMP); float* rsq = (float*)(ws + WS_RSQ);

#ifdef EXTRA_SYNC
    for (int rep_ = 0; rep_ < EXTRA_SYNC; ++rep_) GRID_BAR();
#endif
    if ((int)blockIdx.x == G - 1 && tid < 256) ((float*)(ws + WS_GT))[tid] = p.in[8 + (tid >> 6)][tid & 63];
    if (G > 128) { if (blockIdx.x < 96) p0_mod(p, L, tid, wave, lane); else p0_weights(p, L, (blockIdx.x - 96) * NWAVES + wave, (G - 96) * NWAVES, wave, lane); }
    else { if (blockIdx.x < 96) p0_mod(p, L, tid, wave, lane); p0_weights(p, L, gw, ngw, wave, lane); }
    GRID_BAR();
    p0b_rows(p, L, tid, gw, ngw, lane);
    p0b_c2(p, L, tid, gw, ngw, lane);
    GRID_BAR();
#ifndef NO_P1
    for (int rep_ = 0; rep_ < REP_P1; ++rep_) {
    {
        pg8::Gemm g{XN, Wt_in, MROWS, NQKV, DM}; pg8::StaticOrder S; S.init(MROWS, NQKV, G, (int)blockIdx.x);
        pg8::EpiInProj E{QKV, (const float*)(ws + WS_GT), kmp};
        pg8::gemm_phase<pg8::EpiInProj, pg8::StaticOrder, true, true>(L, g, S, E);
    }
    if (rep_ + 1 < REP_P1) GRID_BAR(); }
#endif
    GRID_BAR();
#ifndef NO_P2
    for (int rep_ = 0; rep_ < REP_P2; ++rep_) {
    {
        const int vcu = (G % 8 == 0) ? (int)(blockIdx.x % 8) * (G / 8) + (int)(blockIdx.x / 8) : (int)blockIdx.x;
        const int xg = (vcu * 8) / G;
        const attn_body::bf16* qkv = (const attn_body::bf16*)QKV; attn_body::bf16* att = (attn_body::bf16*)ATT;
        const attn_body::u32x2v* kaug = (const attn_body::u32x2v*)(ws + WS_KAUG); const float* fl2 = (const float*)(ws + WS_FL2); const float* gt = (const float*)(ws + WS_GT);
        const int* t0tab = (const int*)(ws + WS_T0);
        if (rep_ == 0 && blockIdx.x < 64) { p1_scan(p, L, tid); flag_arrive((unsigned*)(ws + WS_CTL) + CTL_SCANCNT); }
        {
            unsigned* ctr = (unsigned*)(ws + WS_CTL) + 4096 + 64 * (8 + xg) + 1024 * rep_;
            if (tid == 0) MISC[0] = __hip_atomic_fetch_add(ctr, 1u, __ATOMIC_RELAXED, __HIP_MEMORY_SCOPE_AGENT);
            __syncthreads();
            int cur = (int)MISC[0];
            int pre = 0; attn_body::Seam sm;
#pragma unroll 1
            while (cur < 128) { const int qb = 15 - (cur >> 3), bh = 8 * xg + (cur & 7);
                cur = attn_body::attn_unit<1>(bh >> 3, bh & 7, qb, 0, qkv, kaug, fl2, kmp, p.in[12], gt, T5B, att, (char*)lds, ctr, MISC, pre, t0tab, sm); pre = 1; }
        }
        __syncthreads();
        {
            unsigned* ctr = (unsigned*)(ws + WS_CTL) + 4096 + 64 * xg + 1024 * rep_;
            flag_wait((unsigned*)(ws + WS_CTL) + CTL_SCANCNT, 64u, (unsigned*)(ws + WS_CTL));
            if (tid == 0) MISC[0] = __hip_atomic_fetch_add(ctr, 1u, __ATOMIC_RELAXED, __HIP_MEMORY_SCOPE_AGENT);
            __syncthreads();
            int cur = (int)MISC[0];
            int pre = 0; attn_body::Seam sm;
            if (tid < 128) ((LAS int*)(L + attn_body::LDS_TAB))[tid] = t0tab[xg * 128 + tid];
            __syncthreads();
#pragma unroll 1
            while (cur < 128) { const int qb = 15 - (cur >> 3), bh = 8 * xg + (cur & 7);
                const int T0 = __builtin_amdgcn_readfirstlane(((const LAS int*)(L + attn_body::LDS_TAB))[(cur & 7) * 16 + qb]);
                cur = attn_body::attn_unit<0>(bh >> 3, bh & 7, qb, T0, qkv, kaug, fl2, kmp, p.in[12], gt, T5B, att, (char*)lds, ctr, MISC, pre, t0tab, sm); pre = 1; }
        }
    }
    if (rep_ + 1 < REP_P2) GRID_BAR(); }
#endif
    GRID_BAR();
#ifndef NO_P3
    for (int rep_ = 0; rep_ < REP_P3; ++rep_) {
    {
        pg8::Gemm g{ATT, Wt_o, MROWS, DM, DM}; pg8::StaticOrder S; S.init(MROWS, DM, G, (int)blockIdx.x);
        pg8::EpiWo E{p.in[0], p.out, XN, mod, p.in[5], rsq, (bf16_t*)(ws + WS_X1B)};
        pg8::gemm_phase<pg8::EpiWo, pg8::StaticOrder, true, true>(L, g, S, E);
    }
    if (rep_ + 1 < REP_P3) GRID_BAR(); }
#endif
    GRID_BAR();
#ifndef NO_P4
    for (int rep_ = 0; rep_ < REP_P4; ++rep_) {
    {
        pg8::Gemm g{XN, Wt_gu, MROWS, NGU, DM}; pg8::StaticOrder S; S.init(MROWS, NGU, G, (int)blockIdx.x);
        pg8::EpiSwiGLU E{Hb, c2, rsq, L + EXT_OFF};
        pg8::gemm_phase<pg8::EpiSwiGLU, pg8::StaticOrder, true, true>(L, g, S, E);
    }
    if (rep_ + 1 < REP_P4) GRID_BAR(); }
#endif
    GRID_BAR();
#ifndef NO_P5
#ifdef REP_P5
    {
        pg8::Gemm g{Hb, Wt_dn, MROWS, DM, DFF}; pg8::StaticOrder S; S.init(MROWS, DM, G, (int)blockIdx.x);
        pg8::EpiDown E{p.out, (float*)(ws + 384 * MiB), mod, (const bf16_t*)(ws + WS_X1B)};
        pg8::gemm_phase<pg8::EpiDown, pg8::StaticOrder, true, true>(L, g, S, E);
    }
    GRID_BAR();
#endif
    {
        pg8::Gemm g{Hb, Wt_dn, MROWS, DM, DFF}; pg8::StaticOrder S; S.init(MROWS, DM, G, (int)blockIdx.x);
        pg8::EpiDown E{p.out, p.out, mod, (const bf16_t*)(ws + WS_X1B)};
        pg8::gemm_phase<pg8::EpiDown, pg8::StaticOrder, true, true>(L, g, S, E);
    }
#endif
}

extern "C" void kernel_launch(void* const* d_in, const int* in_sizes, int n_in, void* d_out, int out_size, void* d_ws, size_t ws_size, hipStream_t stream) {
    static int grid = 0;
    if (grid == 0) {
        int dev = 0, cus = 0, per_cu = 0;
        hipGetDevice(&dev);
        hipDeviceGetAttribute(&cus, hipDeviceAttributeMultiprocessorCount, dev);
        hipFuncSetAttribute((const void*)mega_fwd, hipFuncAttributeMaxDynamicSharedMemorySize, LDS_BYTES);
        hipOccupancyMaxActiveBlocksPerMultiprocessor(&per_cu, (const void*)mega_fwd, NTHREADS, LDS_BYTES);
        if (per_cu < 1) { fprintf(stderr, "kernel_launch: occupancy query says %d blocks/CU\n", per_cu); per_cu = 1; }
        if (per_cu > 1) per_cu = 1;
        grid = cus * per_cu;
        if (n_in != 17 || ws_size < WS_END) fprintf(stderr, "kernel_launch: unexpected n_in %d / ws_size %zu\n", n_in, ws_size);
    }
    Params p{};
    for (int i = 0; i < 17; ++i) p.in[i] = (const float*)d_in[i];
    p.out = (float*)d_out; p.ws = (unsigned char*)d_ws;
    if (hipMemsetAsync((char*)d_ws + WS_CTL, 0, CTL_BYTES, stream) != hipSuccess) fprintf(stderr, "kernel_launch: memset of the barrier words failed\n");
    void* args[] = {&p};
    hipError_t e = hipLaunchCooperativeKernel((const void*)mega_fwd, dim3(grid), dim3(NTHREADS), args, LDS_BYTES, stream);
    if (e != hipSuccess) fprintf(stderr, "launch failed: %s (grid %d)\n", hipGetErrorString(e), grid);
}
```

```cpp
#include <hip/hip_runtime.h>
#include <hip/hip_cooperative_groups.h>
#include <cstdio>
#include <cstdint>
namespace cg = cooperative_groups;
#ifndef X1_BF16
#define X1_BF16 1
#endif
#define NT_X 1
#define NT_RL 1
#define NT_P0 1
#define NT_Q 1

constexpr int NB = 8, SEQ = 4096, DM = 1024, MROWS = NB * SEQ, DH = 64, INC = 3080, DFF = 2816, NQKV = 3072, NGU = 2 * DFF;
constexpr float EPS = 1e-6f;
constexpr float LOG2E = 1.4426950408889634f;
constexpr float QSCALE = 0.125f * LOG2E;
constexpr size_t MiB = 1u << 20;
constexpr size_t WS_MOD = 0;
constexpr size_t WS_C2 = 256 * 1024;
constexpr size_t WS_GT = 448 * 1024;
constexpr size_t WS_T0 = 452 * 1024;
constexpr size_t WS_CTL = 512 * 1024, CTL_BYTES = 32768;
constexpr size_t WS_LOGF = 1 * MiB;
constexpr size_t WS_FL2 = 2 * MiB;
constexpr size_t WS_KAUG = 3 * MiB;
constexpr size_t WS_KMP = 5 * MiB;
constexpr size_t WS_RSQ = 6 * MiB;
constexpr size_t WS_WIN = 8 * MiB, WS_WO = 14 * MiB, WS_WGU = 16 * MiB, WS_WDN = 28 * MiB;
constexpr size_t WS_XN = 64 * MiB;
constexpr size_t WS_QKV = 128 * MiB;
constexpr size_t WS_H = 128 * MiB;
constexpr size_t WS_ATT = 320 * MiB;
constexpr size_t WS_X1B = 448 * MiB;
constexpr size_t WS_END = 512 * MiB;

typedef float f32x4 __attribute__((ext_vector_type(4)));
typedef unsigned u32x2 __attribute__((ext_vector_type(2)));
typedef unsigned u32x4 __attribute__((ext_vector_type(4)));

__device__ const unsigned char T5B[128] = {0, 1, 2, 3, 4, 5, 6, 7, 8, 9, 10, 11, 12, 13, 14, 15, 16, 16, 16, 17, 17, 18, 18, 18, 19, 19, 19, 20, 20, 20, 20, 21, 21, 21, 21, 22, 22, 22, 22, 22, 23, 23, 23, 23, 23, 23, 24, 24, 24, 24, 24, 24, 25, 25, 25, 25, 25, 25, 25, 26, 26, 26, 26, 26, 26, 26, 26, 27, 27, 27, 27, 27, 27, 27, 27, 27, 27, 28, 28, 28, 28, 28, 28, 28, 28, 28, 28, 29, 29, 29, 29, 29, 29, 29, 29, 29, 29, 29, 29, 30, 30, 30, 30, 30, 30, 30, 30, 30, 30, 30, 30, 30, 30, 31, 31, 31, 31, 31, 31, 31, 31, 31, 31, 31, 31, 31, 31, 31};

__device__ __forceinline__ unsigned f2bf(float f) { unsigned u = __float_as_uint(f); return (u + 0x7fffu + ((u >> 16) & 1u)) >> 16; }
typedef float f32x2_hw __attribute__((ext_vector_type(2))); typedef __bf16 bf16x2_hw __attribute__((ext_vector_type(2)));
__device__ __forceinline__ unsigned pk2(float lo, float hi) { const f32x2_hw v = {lo, hi}; return __builtin_bit_cast(unsigned, __builtin_convertvector(v, bf16x2_hw)); }
__device__ __forceinline__ float bf2f(unsigned h) { return __uint_as_float(h << 16); }
template <int CTRL> __device__ __forceinline__ float dppf(float v) { return __builtin_bit_cast(float, __builtin_amdgcn_update_dpp(0, __builtin_bit_cast(int, v), CTRL, 0xf, 0xf, true)); }
__device__ __forceinline__ float lx1(float v) { return dppf<0xB1>(v); }
__device__ __forceinline__ float lx2(float v) { return dppf<0x4E>(v); }
__device__ __forceinline__ float lx4(float v, bool bit2) { const float up = dppf<0x104>(v), dn = dppf<0x114>(v); return bit2 ? dn : up; }
__device__ __forceinline__ float lx8(float v) { return dppf<0x128>(v); }
__device__ __forceinline__ float addx16(float v) { auto r = __builtin_amdgcn_permlane16_swap(__float_as_uint(v), __float_as_uint(v), false, false); return __uint_as_float(r[0]) + __uint_as_float(r[1]); }
__device__ __forceinline__ float addx32(float v) { auto r = __builtin_amdgcn_permlane32_swap(__float_as_uint(v), __float_as_uint(v), false, false); return __uint_as_float(r[0]) + __uint_as_float(r[1]); }
__device__ __forceinline__ float wave_sum(float v) {
    v += lx1(v); v += lx2(v); v += dppf<0x141>(v)  ; v += dppf<0x140>(v)  ; v = addx16(v); v = addx32(v);
    return v;
}
#ifndef PG8_WGM
#define PG8_WGM 4
#endif
namespace pg8 {
#define PG8_LAS __attribute__((address_space(3)))
typedef unsigned short bf16_t;
typedef short bf16x8 __attribute__((ext_vector_type(8)));
typedef float f32x4 __attribute__((ext_vector_type(4)));
typedef unsigned u32x4 __attribute__((ext_vector_type(4)));
constexpr int BM = 256, BK = 64, HALF = 128, HTB = HALF * BK * 2  , STAGE_BYTES = 8 * HTB, NXCD = 8, WGM = PG8_WGM;

__host__ __device__ __forceinline__ int lds_byte(int r, int c) { const int st = (r >> 4) * 2 + (c >> 5), rr = r & 15, cc = c & 31, ob = rr * 64 + cc * 2; return st * 1024 + (ob ^ (((ob >> 9) & 1) << 5)); }
__host__ __device__ __forceinline__ void stage_rc(int b, int& R, int& C) { const int st = b / 1024, sb = b % 1024, swz = sb ^ (((sb >> 9) & 1) << 5); R = (st >> 1) * 16 + swz / 64; C = (st & 1) * 32 + (swz % 64) / 2; }
__host__ __device__ __forceinline__ int perm32(int rho) { const int n = rho >> 4, i = rho & 15; return 8 * (i >> 2) + 4 * n + (i & 3); }

struct Unit { int pm, pn; };
struct Gemm { const bf16_t* A; const bf16_t* Bt; int M, N, K; };

struct StaticOrder {
    int nM, nN, nwg, G, c;
    __host__ __device__ void init(int M, int N, int G_, int c_) { nM = M / BM; nN = N / BM; nwg = nM * nN; G = G_; c = c_; }
    __host__ __device__ bool next(int i, Unit& u) const {
        const long L = (long)i * G + c; if (L >= nwg) return false;
        int wgid = (int)L; { const int q = nwg / NXCD, r = nwg % NXCD, xcd = wgid % NXCD, off = wgid / NXCD; wgid = (xcd < r ? xcd * (q + 1) : r * (q + 1) + (xcd - r) * q) + off; }
        const int nig = WGM * nN, gid = wgid / nig, fm = gid * WGM, gsz = (nM - fm) < WGM ? (nM - fm) : WGM;
        u.pm = fm + ((wgid % nig) % gsz); u.pn = (wgid % nig) / gsz; return true;
    }
    __device__ __forceinline__ void a_ready(const Unit&) const {}
    __device__ __forceinline__ void done(const Unit&) const {}
};
__device__ __forceinline__ unsigned cvt_pk_bf16(float lo, float hi) { unsigned r; asm volatile("v_cvt_pk_bf16_f32 %0, %1, %2" : "=v"(r) : "v"(lo), "v"(hi)); return r; }
typedef float f32x2 __attribute__((ext_vector_type(2)));
#ifdef NT_X
#define LDXE(p) __builtin_nontemporal_load((const f32x4*)(p))
#else
#define LDXE(p) (*(const f32x4*)(p))
#endif
#ifdef NT_RL
#define NT_LD16(p) __builtin_nontemporal_load((const u32x4*)(p))
#else
#define NT_LD16(p) (*(const u32x4*)(p))
#endif
#ifdef NT_RS
#define NT_ST16(p, v) __builtin_nontemporal_store((v), (u32x4*)(p))
#else
#define NT_ST16(p, v) (*(u32x4*)(p) = (v))
#endif
#ifdef NT_RO
#define NT_ST16F(p, v) __builtin_nontemporal_store((v), (f32x4*)(p))
#else
#define NT_ST16F(p, v) (*(f32x4*)(p) = (v))
#endif
struct EpiInProj {
    static constexpr bool PERM = true, AFTER_DRAIN = false, PRELOAD = false; static constexpr int NSTORE = 16;
    bf16_t* O; const float* gtab; float* kmp;
    __device__ __forceinline__ void operator()(const f32x4 (&acc)[2][2][4][2], const Unit& u, int wr, int wc, int fr, int fq) const {
        const int sec = u.pn >> 1, head = 4 * (u.pn & 1) + wc;
        const bool nrm = (sec != 2 && sec != 5);
        const float* gp = gtab + 64 * (sec - (sec >= 3 ? 1 : 0));
        const float qs = (sec == 0 || sec == 3) ? QSCALE : 1.f;
        f32x4 gv[2][2]; float rinvs[2][4];
#pragma unroll
        for (int bj = 0; bj < 2; ++bj)
#pragma unroll
            for (int n = 0; n < 2; ++n) gv[bj][n] = nrm ? *(const f32x4*)(gp + 32 * bj + 8 * fq + 4 * n) * qs : (f32x4){1.f, 1.f, 1.f, 1.f};
        bf16_t* obase = O + (size_t)(u.pm * BM + wr * 64 + fr) * NQKV + 512 * sec + 64 * head + 8 * fq;
#pragma unroll
        for (int ai = 0; ai < 2; ++ai)
#pragma unroll
            for (int m = 0; m < 4; ++m) {
                float rinv = 1.f;
                if (nrm) {
                    typedef float f32x2_ __attribute__((ext_vector_type(2)));
                    f32x2_ s2 = {0.f, 0.f}, s3 = {0.f, 0.f};
#pragma unroll
                    for (int bj = 0; bj < 2; ++bj)
#pragma unroll
                        for (int n = 0; n < 2; ++n) { const f32x4 v = acc[ai][bj][m][n]; const f32x2_ a = {v[0], v[1]}, b = {v[2], v[3]}; s2 = __builtin_elementwise_fma(a, a, s2); s3 = __builtin_elementwise_fma(b, b, s3); }
                    float ss = (s2.x + s2.y) + (s3.x + s3.y);
                    ss = ::addx16(ss); ss = ::addx32(ss);
                    rinv = __builtin_amdgcn_rsqf(ss * (1.0f / 64.0f) + EPS);
                }
                rinvs[ai][m] = rinv;
                bf16_t* rowp = obase + (size_t)(ai * HALF + m * 16) * NQKV;
#pragma unroll
                for (int bj = 0; bj < 2; ++bj) {
                    const f32x4 v0 = acc[ai][bj][m][0] * rinv * gv[bj][0], v1 = acc[ai][bj][m][1] * rinv * gv[bj][1];
                    u32x4 w; w.x = cvt_pk_bf16(v0[0], v0[1]); w.y = cvt_pk_bf16(v0[2], v0[3]); w.z = cvt_pk_bf16(v1[0], v1[1]); w.w = cvt_pk_bf16(v1[2], v1[3]);
                    *(u32x4*)(rowp + 32 * bj) = w;
                }
            }
        if (sec == 4) {
            const int b = u.pm >> 4, nblk = u.pm & 15;
            float* dst = kmp + ((size_t)(((b * 8 + head) * 16 + nblk) * 2 + wr)) * 64 + 8 * fq;
#pragma unroll
            for (int bj = 0; bj < 2; ++bj)
#pragma unroll
                for (int n = 0; n < 2; ++n) {
                    f32x4 cs = (f32x4){0.f, 0.f, 0.f, 0.f};
#pragma unroll
                    for (int ai = 0; ai < 2; ++ai)
#pragma unroll
                        for (int m = 0; m < 4; ++m) cs += acc[ai][bj][m][n] * rinvs[ai][m];
                    cs *= gv[bj][n];
#pragma unroll
                    for (int e = 0; e < 4; ++e) { float t = cs[e]; t += ::lx1(t); t += ::lx2(t); t += ::dppf<0x141>(t); t += ::dppf<0x140>(t); cs[e] = t; }
                    if (fr == 0) *(f32x4*)(dst + 32 * bj + 4 * n) = cs;
                }
        }
    }
};
struct EpiWo {
    static constexpr bool PERM = true, AFTER_DRAIN = false, PRELOAD = false; static constexpr int NSTORE = 18;
    const float* x; float* out; bf16_t* xn; const float* mod; const float* norm2; float* rsq; bf16_t* x1b;
    __device__ __forceinline__ void operator()(const f32x4 (&acc)[2][2][4][2], const Unit& u, int wr, int wc, int fr, int fq) const {
        const int b = u.pm >> 4, col0 = u.pn * BM + wc * 32 + 8 * fq;
        f32x4 g1[2][2], gm[2][2];
#pragma unroll
        for (int bj = 0; bj < 2; ++bj)
#pragma unroll
            for (int n = 0; n < 2; ++n) { const int c = col0 + bj * HALF + 4 * n;
                g1[bj][n] = *(const f32x4*)(mod + b * 6144 + 2 * 1024 + c);
                gm[bj][n] = *(const f32x4*)(norm2 + c) * (*(const f32x4*)(mod + b * 6144 + 4 * 1024 + c) + 1.0f); }
#pragma unroll
        for (int am = 0; am < 8; am += 2) {
            f32x4 xv[2][2][2];
#pragma unroll
            for (int q = 0; q < 2; ++q) { const int ai = (am + q) >> 2, m = (am + q) & 3; const size_t off = (size_t)(u.pm * BM + ai * HALF + wr * 64 + m * 16 + fr) * DM + col0;
#pragma unroll
                for (int bj = 0; bj < 2; ++bj)
#pragma unroll
                    for (int n = 0; n < 2; ++n) xv[q][bj][n] = LDXE(x + off + bj * HALF + 4 * n); }
            asm volatile("" ::: "memory");
#pragma unroll
            for (int q = 0; q < 2; ++q) {
                const int ai = (am + q) >> 2, m = (am + q) & 3;
                const int row = u.pm * BM + ai * HALF + wr * 64 + m * 16 + fr; const size_t off = (size_t)row * DM + col0; float ss = 0.f;
#pragma unroll
                for (int bj = 0; bj < 2; ++bj) {
                    const f32x4 a0 = xv[q][bj][0] + g1[bj][0] * acc[ai][bj][m][0], a1 = xv[q][bj][1] + g1[bj][1] * acc[ai][bj][m][1];
#if X1_BF16
                    { u32x4 wx; wx.x = cvt_pk_bf16(a0[0], a0[1]); wx.y = cvt_pk_bf16(a0[2], a0[3]); wx.z = cvt_pk_bf16(a1[0], a1[1]); wx.w = cvt_pk_bf16(a1[2], a1[3]); NT_ST16(x1b + off + bj * HALF, wx); }
#else
                    *(f32x4*)(out + off + bj * HALF) = a0; *(f32x4*)(out + off + bj * HALF + 4) = a1;
#endif
                    { typedef float f32x2_ __attribute__((ext_vector_type(2))); const f32x2_ p0 = {a0[0], a0[1]}, p1 = {a0[2], a0[3]}, p2 = {a1[0], a1[1]}, p3 = {a1[2], a1[3]};
                      f32x2_ q = p0 * p0; q = __builtin_elementwise_fma(p1, p1, q); f32x2_ q2 = p2 * p2; q2 = __builtin_elementwise_fma(p3, p3, q2); q += q2; ss += q.x + q.y; }
                    const f32x4 y0 = a0 * gm[bj][0], y1 = a1 * gm[bj][1];
                    u32x4 wy; wy.x = cvt_pk_bf16(y0[0], y0[1]); wy.y = cvt_pk_bf16(y0[2], y0[3]); wy.z = cvt_pk_bf16(y1[0], y1[1]); wy.w = cvt_pk_bf16(y1[2], y1[3]);
                    *(u32x4*)(xn + off + bj * HALF) = wy;
                }
                ss = ::addx16(ss); ss = ::addx32(ss);
                if (fq == 0) rsq[(size_t)row * 16 + 4 * u.pn + wc] = ss;
            }
            asm volatile("" ::: "memory");
        }
    }
};
struct EpiSwiGLU {
    static constexpr bool PERM = true, AFTER_DRAIN = false, PRELOAD = true; static constexpr int NSTORE = 8;
    bf16_t* H; const float* c2; const float* rsq; PG8_LAS unsigned char* ext;
    __device__ __forceinline__ void preload(const Unit& u, int wid, int lane) const {
        const char* src = (const char*)(rsq + (size_t)u.pm * BM * 16) + lane * 16;
#pragma unroll
        for (int i = 0; i < 2; ++i) { const int pc = wid * 2 + i; __builtin_amdgcn_global_load_lds((const unsigned*)(src + pc * 1024), (PG8_LAS unsigned*)(ext + pc * 1024), 16, 0, 0); }
        if (wid == 0) __builtin_amdgcn_global_load_lds((const unsigned*)((const char*)(c2 + (u.pm >> 4) * NGU + u.pn * 256) + lane * 16), (PG8_LAS unsigned*)(ext + 16384), 16, 0, 0);
    }
    __device__ __forceinline__ void operator()(const f32x4 (&acc)[2][2][4][2], const Unit& u, int wr, int wc, int fr, int fq) const {
        const int hc = u.pn * 128 + wc * 32 + 8 * fq;
        f32x4 cg[2], cu[2];
        { const PG8_LAS float* cl = (const PG8_LAS float*)(ext + 16384) + wc * 32 + 8 * fq;
#pragma unroll
        for (int n = 0; n < 2; ++n) { cg[n] = *(const PG8_LAS f32x4*)(cl + 4 * n); cu[n] = *(const PG8_LAS f32x4*)(cl + 128 + 4 * n); } }
        f32x4 cgn[2]; cgn[0] = cg[0] * (-LOG2E); cgn[1] = cg[1] * (-LOG2E);
        f32x4 pr[2][4];
#pragma unroll
        for (int ai = 0; ai < 2; ++ai)
#pragma unroll
            for (int m = 0; m < 4; ++m) pr[ai][m] = *(const PG8_LAS f32x4*)(ext + (ai * HALF + wr * 64 + m * 16 + fr) * 64 + 16 * fq);
        float rstd[2][4];
#pragma unroll
        for (int ai = 0; ai < 2; ++ai)
#pragma unroll
            for (int m = 0; m < 4; ++m) { float t = (pr[ai][m][0] + pr[ai][m][1]) + (pr[ai][m][2] + pr[ai][m][3]); t = ::addx16(t); t = ::addx32(t); rstd[ai][m] = __builtin_amdgcn_rsqf(t * (1.0f / 1024.0f) + EPS); }
#pragma unroll
        for (int ai = 0; ai < 2; ++ai)
#pragma unroll
            for (int m = 0; m < 4; ++m) {
                const int row = u.pm * BM + ai * HALF + wr * 64 + m * 16 + fr;
                const float rs = rstd[ai][m], rsn = -rs * LOG2E;
                typedef float f32x2_ __attribute__((ext_vector_type(2)));
                const f32x2_ rs2 = {rs, rs}, rsn2 = {rsn, rsn};
                unsigned wq[4];
#pragma unroll
                for (int n = 0; n < 2; ++n)
#pragma unroll
                    for (int pp = 0; pp < 2; ++pp) {
                        const f32x2_ ag = {acc[ai][0][m][n][2 * pp], acc[ai][0][m][n][2 * pp + 1]}, au = {acc[ai][1][m][n][2 * pp], acc[ai][1][m][n][2 * pp + 1]};
                        const f32x2_ cgp = {cg[n][2 * pp], cg[n][2 * pp + 1]}, cup = {cu[n][2 * pp], cu[n][2 * pp + 1]}, cgnp = {cgn[n][2 * pp], cgn[n][2 * pp + 1]};
                        const f32x2_ g = __builtin_elementwise_fma(ag, rs2, cgp), uu = __builtin_elementwise_fma(au, rs2, cup), ge = __builtin_elementwise_fma(ag, rsn2, cgnp);
                        const f32x2_ e2 = {__builtin_amdgcn_exp2f(ge.x), __builtin_amdgcn_exp2f(ge.y)};
                        const f32x2_ d2 = e2 + 1.0f;
                        const f32x2_ r2 = {__builtin_amdgcn_rcpf(d2.x), __builtin_amdgcn_rcpf(d2.y)};
                        const f32x2_ hp = (g * uu) * r2;
                        wq[2 * n + pp] = cvt_pk_bf16(hp.x, hp.y);
                    }
                u32x4 w; w.x = wq[0]; w.y = wq[1]; w.z = wq[2]; w.w = wq[3];
                *(u32x4*)(H + (size_t)row * DFF + hc) = w;
            }
    }
};
struct EpiDown {
    static constexpr bool PERM = true, AFTER_DRAIN = false, PRELOAD = false; static constexpr int NSTORE = 16;
    const float* xin; float* out; const float* mod; const bf16_t* x1b;
    __device__ __forceinline__ void operator()(const f32x4 (&acc)[2][2][4][2], const Unit& u, int wr, int wc, int fr, int fq) const {
        const int b = u.pm >> 4, col0 = u.pn * BM + wc * 32 + 8 * fq;
        f32x4 g2[2][2];
#pragma unroll
        for (int bj = 0; bj < 2; ++bj)
#pragma unroll
            for (int n = 0; n < 2; ++n) g2[bj][n] = *(const f32x4*)(mod + b * 6144 + 5 * 1024 + col0 + bj * HALF + 4 * n);
#pragma unroll
        for (int ai = 0; ai < 2; ++ai) {
            f32x4 xv[4][2][2];
#pragma unroll
            for (int m = 0; m < 4; ++m) { const size_t off = (size_t)(u.pm * BM + ai * HALF + wr * 64 + m * 16 + fr) * DM + col0;
#pragma unroll
                for (int bj = 0; bj < 2; ++bj) {
#if X1_BF16
                    const u32x4 wx = NT_LD16(x1b + off + bj * HALF);
                    xv[m][bj][0] = (f32x4){__uint_as_float(wx.x << 16), __uint_as_float(wx.x & 0xffff0000u), __uint_as_float(wx.y << 16), __uint_as_float(wx.y & 0xffff0000u)};
                    xv[m][bj][1] = (f32x4){__uint_as_float(wx.z << 16), __uint_as_float(wx.z & 0xffff0000u), __uint_as_float(wx.w << 16), __uint_as_float(wx.w & 0xffff0000u)};
#else
                    xv[m][bj][0] = *(const f32x4*)(xin + off + bj * HALF); xv[m][bj][1] = *(const f32x4*)(xin + off + bj * HALF + 4);
#endif
                } }
            asm volatile("" ::: "memory");
#pragma unroll
            for (int m = 0; m < 4; ++m) { const size_t off = (size_t)(u.pm * BM + ai * HALF + wr * 64 + m * 16 + fr) * DM + col0;
#pragma unroll
                for (int bj = 0; bj < 2; ++bj)
#pragma unroll
                    for (int n = 0; n < 2; ++n) NT_ST16F(out + off + bj * HALF + 4 * n, xv[m][bj][n] + g2[bj][n] * acc[ai][bj][m][n]); }
            asm volatile("" ::: "memory");
        }
    }
};

template <class Epi, class Sched, bool ALIGN_EPI = false, bool SP2 = false>
__device__ __forceinline__ void gemm_phase(PG8_LAS unsigned char* lds, const Gemm g, const Sched& S, const Epi& E) {
    int tid_ = threadIdx.x; asm volatile("" : "+v"(tid_));
    const int tid = tid_, wid = __builtin_amdgcn_readfirstlane(tid >> 6), lane = tid & 63, wr = wid >> 2, wc = wid & 3, fr = lane & 15, fq = lane >> 4;
    const int K = g.K, nt = K / BK;
    unsigned voffA[2], voffB[2];
#pragma unroll
    for (int i = 0; i < 2; ++i) { int R, C; stage_rc(tid * 16 + i * 8192, R, C); const int Rb = Epi::PERM ? ((R & ~31) + perm32(R & 31)) : R;
        voffA[i] = (unsigned)(R * K + C) * 2u; voffB[i] = (unsigned)(Rb * K + C) * 2u; }
    const size_t kstep = (size_t)(BK * 2);
    const size_t hstep = (size_t)HALF * K * 2;
    const size_t tstep = 2 * hstep;
    const unsigned ldsw = (unsigned)wid * 1024u;
    const int aoff = lds_byte(wr * 64 + fr, fq * 8), boff = lds_byte(wc * 32 + fr, fq * 8);
#define PG8_SA(b, h) (((b) * 2 + (h)) * HTB)
#define PG8_SB(b, h) ((4 + (b) * 2 + (h)) * HTB)
#define PG8_STAGE(bufoff, gbase, voff) do { _Pragma("unroll") for (int _i = 0; _i < 2; ++_i) \
        __builtin_amdgcn_global_load_lds((const unsigned*)((const char*)(gbase) + (voff)[_i]), (PG8_LAS unsigned*)(lds + (bufoff) + ldsw + _i * 8192), 16, 0, 0); } while (0)
#define PG8_LDA(dst, b, h) do { _Pragma("unroll") for (int m = 0; m < 4; ++m) _Pragma("unroll") for (int k = 0; k < 2; ++k) dst[m][k] = *(const PG8_LAS bf16x8*)(lds + PG8_SA(b, h) + aoff + m * 2048 + k * 1024); } while (0)
#define PG8_LDB(dst, b, h) do { _Pragma("unroll") for (int n = 0; n < 2; ++n) _Pragma("unroll") for (int k = 0; k < 2; ++k) dst[n][k] = *(const PG8_LAS bf16x8*)(lds + PG8_SB(b, h) + boff + n * 2048 + k * 1024); } while (0)
#define PG8_MMA(ai, bj, At, Bt) do { __builtin_amdgcn_s_setprio(1); _Pragma("unroll") for (int m = 0; m < 4; ++m) _Pragma("unroll") for (int n = 0; n < 2; ++n) _Pragma("unroll") for (int k = 0; k < 2; ++k) \
        acc[ai][bj][m][n] = __builtin_amdgcn_mfma_f32_16x16x32_bf16(Bt[n][k], At[m][k], acc[ai][bj][m][n], 0, 0, 0); __builtin_amdgcn_s_setprio(0); } while (0)
#define PG8_WAIT_V(n) asm volatile("s_waitcnt vmcnt(" #n ")" ::: "memory")
#define PG8_WAIT_L(n) asm volatile("s_waitcnt lgkmcnt(" #n ")" ::: "memory")
#define PG8_BAR __builtin_amdgcn_s_barrier()
#define PG8_SCHED __builtin_amdgcn_sched_barrier(0)
    Unit cur, nxt; int ui = 0;
    if (!S.next(0, cur)) return;
    f32x4 acc[2][2][4][2];
#pragma unroll
    for (int a = 0; a < 2; ++a)
#pragma unroll
        for (int b = 0; b < 2; ++b)
#pragma unroll
            for (int m = 0; m < 4; ++m)
#pragma unroll
                for (int n = 0; n < 2; ++n) acc[a][b][m][n] = (f32x4){0.f, 0.f, 0.f, 0.f};
    bf16x8 At[4][2], B0[2][2], B1[2][2];
    const char* cA = (const char*)g.A + (size_t)cur.pm * tstep; const char* cB = (const char*)g.Bt + (size_t)cur.pn * tstep;
    S.a_ready(cur);
    if constexpr (SP2) {
        PG8_STAGE(PG8_SB(0, 0), cB, voffB); PG8_STAGE(PG8_SB(0, 1), cB + hstep, voffB); PG8_STAGE(PG8_SA(0, 0), cA, voffA); PG8_STAGE(PG8_SA(0, 1), cA + hstep, voffA);
        if (wr == 1) PG8_BAR;
        PG8_WAIT_V(2); PG8_BAR;
        PG8_STAGE(PG8_SB(1, 0), cB + kstep, voffB); PG8_STAGE(PG8_SA(1, 0), cA + kstep, voffA); PG8_STAGE(PG8_SB(1, 1), cB + hstep + kstep, voffB);
        PG8_WAIT_V(6); PG8_BAR;
    } else {
        PG8_STAGE(PG8_SB(0, 0), cB, voffB); PG8_STAGE(PG8_SA(0, 0), cA, voffA); PG8_STAGE(PG8_SB(0, 1), cB + hstep, voffB); PG8_STAGE(PG8_SA(0, 1), cA + hstep, voffA);
        if (wr == 1) PG8_BAR;
        PG8_WAIT_V(4); PG8_BAR;
        PG8_STAGE(PG8_SB(1, 0), cB + kstep, voffB); PG8_STAGE(PG8_SA(1, 0), cA + kstep, voffA); PG8_STAGE(PG8_SB(1, 1), cB + hstep + kstep, voffB);
        PG8_WAIT_V(6); PG8_BAR;
    }
    for (;;) {
        const bool has_next = S.next(ui + 1, nxt);
        const char* nA = has_next ? (const char*)g.A + (size_t)nxt.pm * tstep : cA; const char* nB = has_next ? (const char*)g.Bt + (size_t)nxt.pn * tstep : cB;
        for (int t = 0; t < nt; t += 2) {
            const bool last = (t == nt - 2);
            const char* a1 = cA + (size_t)(t + 1) * kstep;
            const char* a2 = last ? nA : cA + (size_t)(t + 2) * kstep; const char* b2 = last ? nB : cB + (size_t)(t + 2) * kstep;
            const char* a3 = a2 + kstep; const char* b3 = b2 + kstep;
            if (last && has_next) S.a_ready(nxt);
            if constexpr (Epi::PRELOAD) { if (t == nt - 4) E.preload(cur, wid, lane); }
            if constexpr (SP2) {
            PG8_LDB(B0, 0, 0); PG8_LDB(B1, 0, 1); PG8_SCHED; PG8_LDA(At, 0, 0); PG8_STAGE(PG8_SA(1, 1), a1 + hstep, voffA);
            PG8_WAIT_V(8); PG8_WAIT_L(0); PG8_BAR; PG8_MMA(0, 0, At, B0); PG8_MMA(0, 1, At, B1); PG8_BAR; PG8_SCHED;
            PG8_LDA(At, 0, 1); PG8_STAGE(PG8_SB(0, 0), b2, voffB); PG8_STAGE(PG8_SB(0, 1), b2 + hstep, voffB); PG8_STAGE(PG8_SA(0, 0), a2, voffA);
            PG8_WAIT_V(8); PG8_WAIT_L(0); PG8_BAR; PG8_MMA(1, 0, At, B0); PG8_MMA(1, 1, At, B1); PG8_BAR; PG8_SCHED;
            PG8_LDB(B0, 1, 0); PG8_LDB(B1, 1, 1); PG8_SCHED; PG8_LDA(At, 1, 0); PG8_STAGE(PG8_SA(0, 1), a2 + hstep, voffA);
            PG8_WAIT_V(8); PG8_WAIT_L(0); PG8_BAR; PG8_MMA(0, 0, At, B0); PG8_MMA(0, 1, At, B1); PG8_BAR; PG8_SCHED;
            PG8_LDA(At, 1, 1); PG8_STAGE(PG8_SB(1, 0), b3, voffB); PG8_STAGE(PG8_SB(1, 1), b3 + hstep, voffB); PG8_STAGE(PG8_SA(1, 0), a3, voffA);
            PG8_WAIT_V(8); PG8_WAIT_L(0); PG8_BAR; PG8_MMA(1, 0, At, B0); PG8_MMA(1, 1, At, B1); PG8_BAR; PG8_SCHED;
            } else {
            PG8_LDB(B0, 0, 0); PG8_SCHED; PG8_LDA(At, 0, 0); PG8_STAGE(PG8_SA(1, 1), a1 + hstep, voffA);
            PG8_WAIT_L(8); PG8_BAR; PG8_WAIT_L(0); PG8_MMA(0, 0, At, B0); PG8_BAR; PG8_SCHED;
            PG8_LDB(B1, 0, 1); PG8_STAGE(PG8_SB(0, 0), b2, voffB);
            PG8_BAR; PG8_WAIT_L(0); PG8_MMA(0, 1, At, B1); PG8_BAR;
            PG8_LDA(At, 0, 1); PG8_STAGE(PG8_SA(0, 0), a2, voffA);
            PG8_BAR; PG8_WAIT_L(0); PG8_MMA(1, 0, At, B0); PG8_BAR; PG8_SCHED;
            PG8_STAGE(PG8_SB(0, 1), b2 + hstep, voffB);
            PG8_WAIT_V(6); PG8_BAR; PG8_MMA(1, 1, At, B1); PG8_BAR;
            PG8_LDB(B0, 1, 0); PG8_SCHED; PG8_LDA(At, 1, 0); PG8_STAGE(PG8_SA(0, 1), a2 + hstep, voffA);
            PG8_WAIT_L(8); PG8_BAR; PG8_WAIT_L(0); PG8_MMA(0, 0, At, B0); PG8_BAR; PG8_SCHED;
            PG8_LDB(B1, 1, 1); PG8_STAGE(PG8_SB(1, 0), b3, voffB);
            PG8_BAR; PG8_WAIT_L(0); PG8_MMA(0, 1, At, B1); PG8_BAR;
            PG8_LDA(At, 1, 1); PG8_STAGE(PG8_SA(1, 0), a3, voffA);
            PG8_BAR; PG8_WAIT_L(0); PG8_MMA(1, 0, At, B0); PG8_BAR; PG8_SCHED;
            PG8_STAGE(PG8_SB(1, 1), b3 + hstep, voffB);
            PG8_WAIT_V(6); PG8_BAR; PG8_MMA(1, 1, At, B1); PG8_BAR;
            }
        }
        if constexpr (ALIGN_EPI) { if (wr == 0) PG8_BAR; }
        if constexpr (!Epi::AFTER_DRAIN) { E(acc, cur, wr, wc, fr, fq); S.done(cur); }
        if (!has_next) break;
#pragma unroll
        for (int a = 0; a < 2; ++a)
#pragma unroll
            for (int b = 0; b < 2; ++b)
#pragma unroll
                for (int m = 0; m < 4; ++m)
#pragma unroll
                    for (int n = 0; n < 2; ++n) acc[a][b][m][n] = (f32x4){0.f, 0.f, 0.f, 0.f};
        cur = nxt; cA = nA; cB = nB; ++ui;
        if constexpr (ALIGN_EPI) { if (wr == 1) PG8_BAR; }
    }
    PG8_WAIT_V(0);
    if constexpr (!ALIGN_EPI) { if (wr == 0) PG8_BAR; }
    PG8_BAR;
    if constexpr (Epi::AFTER_DRAIN) { E.fused(acc, cur, wr, wc, fr, fq, lds, wid, lane); S.done(cur); }
#undef PG8_SA
#undef PG8_SB
#undef PG8_STAGE
#undef PG8_LDA
#undef PG8_LDB
#undef PG8_MMA
#undef PG8_WAIT_V
#undef PG8_WAIT_L
#undef PG8_BAR
#undef PG8_SCHED
}
}
#include <hip/hip_bf16.h>
#ifndef SKIP_MODES
#define SKIP_MODES(M) ((M)==1)
#endif
namespace attn_body {
using bf16=__hip_bfloat16;
using bf16x8=__attribute__((ext_vector_type(8)))short;
using s16x4=__attribute__((ext_vector_type(4)))short;
using f32x16=__attribute__((ext_vector_type(16)))float;
using f32x4v=__attribute__((ext_vector_type(4)))float;
using u32x4=__attribute__((ext_vector_type(4)))unsigned;
using u32x2v=__attribute__((ext_vector_type(2)))unsigned;
constexpr int NHEAD=8,SEQ=4096,D=64,QP=3072,OP=1024;
constexpr int NW=8,QBLK=32,QB=QBLK*NW,KVBLK=64;
__device__ __forceinline__ int crow(int r,int hi){return (r&3)+8*(r>>2)+4*hi;}
#define SBAR() __builtin_amdgcn_sched_barrier(0)
typedef __attribute__((address_space(3))) const char* lds_cptr;
typedef __attribute__((address_space(3))) const float* lds_fptr;
typedef __attribute__((address_space(3))) const unsigned* lds_uptr;
__device__ __forceinline__ void cmask(f32x16&p0,f32x16&p1,int jb,int qrel,int hi){
  const float NEG=-INFINITY; int kb=64*jb+4*hi;
  #pragma unroll
  for(int r=0;r<16;++r){int kv=kb+(r&3)+8*(r>>2); if(kv>qrel)p0[r]=NEG; if(kv+32>qrel)p1[r]=NEG;}
}
__device__ __forceinline__ void bias_add(f32x16&p0,f32x16&p1,int jb,int qrel,int hi,lds_fptr tab){
  const int base=qrel-64*jb-4*hi;
  #pragma unroll
  for(int r=0;r<16;++r){const int d0=base-((r&3)+8*(r>>2)),d1=d0-32; p0[r]+=tab[d0<0?0:d0]; p1[r]+=tab[d1<0?0:d1];}
}

constexpr int NSLOT=3, SLOTB=8192;
constexpr int LDS_K=0, LDS_V=NSLOT*SLOTB, LDS_WS=2*NSLOT*SLOTB, LDS_OST=LDS_WS+NW*64*4, LDS_FAUG=LDS_OST+NW*4096, LDS_TAB=LDS_FAUG+32768, LDS_KM=LDS_TAB+1536, LDS_BYTES=LDS_KM+4096;
__device__ __forceinline__ void glds16(const void*gsrc,unsigned lds_dst){unsigned keep;
  asm volatile("s_mov_b32 %0, m0\n\ts_mov_b32 m0, %2\n\ts_nop 0\n\tglobal_load_lds_dwordx4 %1, off\n\ts_mov_b32 m0, %0":"=&s"(keep):"v"(gsrc),"s"(lds_dst):"memory");}
typedef float f32x2_t __attribute__((ext_vector_type(2))); typedef __bf16 bf16x2_t __attribute__((ext_vector_type(2)));
__device__ __forceinline__ unsigned cvtpk_s(float lo,float hi){f32x2_t v={lo,hi};bf16x2_t b=__builtin_convertvector(v,bf16x2_t);return __builtin_bit_cast(unsigned,b);}
#define WAIT_BAR(N) asm volatile("s_waitcnt vmcnt(" #N ") lgkmcnt(0)\n\ts_barrier":::"memory")
#define MFMA32(a,b,c) __builtin_amdgcn_mfma_f32_32x32x16_bf16(a,b,c,0,0,0)
__device__ __forceinline__ unsigned split3(float x,unsigned&h2){
  const unsigned a=cvtpk_s(x,0.f)&0xffffu; const float r1=x-__uint_as_float(a<<16);
  const unsigned b=cvtpk_s(r1,0.f)&0xffffu; const float r2=r1-__uint_as_float(b<<16);
  h2=cvtpk_s(r2,0.f)&0xffffu; return a|(b<<16);
}
typedef short v4i16_t __attribute__((ext_vector_type(4)));
__device__ __forceinline__ void kload8(bf16x8*kf,lds_cptr kp){
  kf[0]=*(const __attribute__((address_space(3))) bf16x8*)(kp);      kf[1]=*(const __attribute__((address_space(3))) bf16x8*)(kp+512);
  kf[2]=*(const __attribute__((address_space(3))) bf16x8*)(kp+2048); kf[3]=*(const __attribute__((address_space(3))) bf16x8*)(kp+2560);
  kf[4]=*(const __attribute__((address_space(3))) bf16x8*)(kp+4096); kf[5]=*(const __attribute__((address_space(3))) bf16x8*)(kp+4608);
  kf[6]=*(const __attribute__((address_space(3))) bf16x8*)(kp+6144); kf[7]=*(const __attribute__((address_space(3))) bf16x8*)(kp+6656);
}
__device__ __forceinline__ void kload2(bf16x8*kf,lds_cptr kp,int j){ kf[2*j]=*(const __attribute__((address_space(3))) bf16x8*)(kp+j*2048); kf[2*j+1]=*(const __attribute__((address_space(3))) bf16x8*)(kp+j*2048+512); }
__device__ __forceinline__ s16x4 vtr(lds_cptr p){ return __builtin_bit_cast(s16x4,__builtin_amdgcn_ds_read_tr16_b64_v4i16((__attribute__((address_space(3))) v4i16_t*)p)); }
__device__ __forceinline__ void pv(f32x16*o,int vb,bf16x8 pa0,bf16x8 pa1,bf16x8 pa2,bf16x8 pa3){
  #pragma unroll
  for(int d0=0;d0<2;++d0){s16x4 lo[4],hi[4];
    #pragma unroll
    for(int ks=0;ks<4;++ks){
      asm volatile("ds_read_b64_tr_b16 %0,%1 offset:%c2":"=&v"(lo[ks]):"v"(vb),"i"(d0*4096+ks*1024):"memory");
      asm volatile("ds_read_b64_tr_b16 %0,%1 offset:%c2":"=&v"(hi[ks]):"v"(vb),"i"(d0*4096+ks*1024+512):"memory");}
    asm volatile("s_waitcnt lgkmcnt(0)":::"memory");SBAR();
    #define PK(k) (bf16x8){lo[k][0],lo[k][1],lo[k][2],lo[k][3],hi[k][0],hi[k][1],hi[k][2],hi[k][3]}
    o[d0]=MFMA32(pa0,PK(0),o[d0]);
    o[d0]=MFMA32(pa1,PK(1),o[d0]);
    o[d0]=MFMA32(pa2,PK(2),o[d0]);
    o[d0]=MFMA32(pa3,PK(3),o[d0]);
    #undef PK
  }
}
__device__ __forceinline__ float wmax(float v){
  v=fmaxf(v,::lx1(v)); v=fmaxf(v,::lx2(v)); v=fmaxf(v,::dppf<0x141>(v)); v=fmaxf(v,::dppf<0x140>(v));
  { auto r=__builtin_amdgcn_permlane16_swap(__float_as_uint(v),__float_as_uint(v),false,false); v=fmaxf(__uint_as_float(r[0]),__uint_as_float(r[1])); }
  { auto r=__builtin_amdgcn_permlane32_swap(__float_as_uint(v),__float_as_uint(v),false,false); v=fmaxf(__uint_as_float(r[0]),__uint_as_float(r[1])); }
  return v;
}

struct Seam { bf16x8 q[4]; float tabv, km0, km1, base, r0, r31, fq; };
template<int MODE,int LOWW=-1> __device__ __forceinline__ int attn_unit(int b,int h,int qb,int T0,const bf16*__restrict__ QKV,const u32x2v*__restrict__ Kaug,const float*__restrict__ Fl2,const float*__restrict__ kmp,
                                                            const float*__restrict__ relb,const float*__restrict__ gtab,const unsigned char*__restrict__ t5b,bf16*__restrict__ O,char*shm,unsigned*ctr,volatile __attribute__((address_space(3))) unsigned*misc,int pre,const int*__restrict__ t0tab,Seam&sm){
  int tid_=threadIdx.x; asm volatile("":"+v"(tid_));
  const int tid=tid_,lane=tid&63,r32=lane&31,hi=lane>>5; const int wid=__builtin_amdgcn_readfirstlane(tid>>6);
  const int bh=b*NHEAD+h; const long rowbase=(long)b*SEQ; const int q0=qb*QB;
  const int cq=(MODE?1536:0)+h*D;
  const bf16*Qw=QKV+(rowbase+q0+wid*QBLK)*QP+cq;
  const bf16*Kh=QKV+rowbase*QP+cq+512,*Vh=QKV+rowbase*QP+cq+1024;
  const unsigned lds0=(unsigned)(uintptr_t)shm;
  float*wsf=(float*)(shm+LDS_WS)+wid*64;
  const bf16*ksrc=Kh+(long)(lane+T0*KVBLK)*QP+wid*8;
  const bf16*vsrc=Vh+(long)(16*(wid&3)+(lane>>2)+T0*KVBLK)*QP+(wid>>2)*32+(lane&3)*8;
  const unsigned kdst=lds0+LDS_K+wid*1024, vdst=lds0+LDS_V+wid*1024;
  #define DMA_K(t,slot) glds16(ksrc+(long)(t)*KVBLK*QP,(unsigned)__builtin_amdgcn_readfirstlane(kdst+(slot)))
  #define DMA_V(t,slot) glds16(vsrc+(long)(t)*KVBLK*QP,(unsigned)__builtin_amdgcn_readfirstlane(vdst+(slot)))
  const int vb0=(int)(lds0+LDS_V)+((lane>>4)&1)*32+(lane&3)*8+(4*hi+((lane&15)>>2))*64;
  const char*Kbase=shm+LDS_K; bf16x8 kf[8];
  const lds_cptr shm3=(lds_cptr)shm; const lds_cptr kp0=shm3+LDS_K+hi*1024+r32*16; const lds_cptr vp0=shm3+LDS_V+((lane>>4)&1)*32+(lane&3)*8+(4*hi+((lane&15)>>2))*64;
  const lds_uptr fau=(lds_uptr)(shm3+LDS_FAUG)+128*T0+r32*2+hi;
  const lds_fptr tabp=(lds_fptr)(shm3+LDS_TAB);
  const int NTA=(q0+QB)/KVBLK, NT=NTA-T0;
  unsigned nxt_=0u; if(tid==0)nxt_=__builtin_amdgcn_atomic_inc32(ctr,0xffffffffu,__ATOMIC_RELAXED,"agent");
  if(!pre){DMA_K(0,0);} DMA_V(0,0); if(!pre){DMA_K(1,SLOTB);}
  bf16x8 qr[4];
  if(pre){
    #pragma unroll
    for(int d0=0;d0<4;++d0)qr[d0]=sm.q[d0];
  }else{
    #pragma unroll
    for(int d0=0;d0<4;++d0)qr[d0]=__builtin_nontemporal_load(reinterpret_cast<const bf16x8*>(&Qw[(long)r32*QP+d0*16+hi*8]));
    asm volatile("":"+v"(qr[0]),"+v"(qr[1]),"+v"(qr[2]),"+v"(qr[3]));
  }
  if(MODE==0){
    if(!pre){ const char*src=(const char*)(Kaug+(size_t)bh*SEQ+KVBLK*T0)+lane*16;
      for(int pc=wid;pc<NT/2;pc+=NW)glds16(src+pc*1024,(unsigned)__builtin_amdgcn_readfirstlane(lds0+LDS_FAUG+KVBLK*T0*8+pc*1024)); }
  }else{
    float tv=0.f,k0v,k1v;
    if(pre){ tv=sm.tabv; k0v=sm.km0; k1v=sm.km1; }
    else { if(tid<113)tv=(relb[t5b[tid]*8+h]-relb[31*8+h])*1.4426950408889634f;
      const float*p0=kmp+((size_t)((bh*16+(tid>>6))*2))*64+(tid&63); const float*p1=kmp+((size_t)((bh*16+8+(tid>>6))*2))*64+(tid&63); k0v=p0[0]+p0[64]; k1v=p1[0]+p1[64]; asm volatile("":"+v"(tv),"+v"(k0v),"+v"(k1v)); }
    float*tb=(float*)(shm+LDS_TAB); if(tid<384)tb[tid]=tv;
    float*kmw=(float*)(shm+LDS_KM); kmw[tid]=k0v; kmw[tid+512]=k1v;
  }
  float Bnd,basev;
  if(pre){ basev=sm.base; Bnd=basev;
    if(MODE==1){ const float bv=lane<32?(sm.r0-sm.r31)*1.4426950408889634f:0.f; Bnd+=fmaxf(wmax(bv),0.f); } }
  else { const float gq=fabsf(gtab[(MODE?128:0)+lane]),gk=fabsf(gtab[(MODE?192:64)+lane]);
    basev=64.f*wmax(gq)*wmax(gk)*(0.125f*1.4426950408889634f)*1.02f+0.25f; Bnd=basev;
    if(MODE==1){ const float bv=lane<32?(relb[lane*8+h]-relb[31*8+h])*1.4426950408889634f:0.f; Bnd+=fmaxf(wmax(bv),0.f); } asm volatile("":"+v"(Bnd),"+v"(basev)); }
  basev=__uint_as_float(__builtin_amdgcn_readfirstlane(__float_as_uint(basev)));
  float fq_row=0.f; if(MODE==0){ if(pre)fq_row=sm.fq; else { fq_row=Fl2[(size_t)bh*SEQ+q0+wid*QBLK+r32]; asm volatile("":"+v"(fq_row)); } }
  float l_reg=0.f;f32x16 o[2];o[0]=f32x16{};o[1]=f32x16{};
  const int qrel=wid*QBLK+r32;
  #define BANDMASK(P0,P1,t) do{int jb_=(t)-(NT-4); if(MODE==1&&jb_>=-2&&(32*wid-64*jb_<176))bias_add(P0,P1,jb_,qrel,hi,tabp); if(jb_>=(wid>>1))cmask(P0,P1,jb_,qrel,hi); }while(0)
  f32x16 pA0,pA1,pB0,pB1;
  int sl_prev=0,sl_cur=0,sl_next=SLOTB;
  #define ROT() do{sl_prev=sl_cur;sl_cur=sl_next;sl_next=(sl_next==(NSLOT-1)*SLOTB)?0:sl_next+SLOTB;}while(0)
  if(!pre){DMA_K(2,2*SLOTB);}
  WAIT_BAR(3);
  unsigned smask=1u<<qb;
  if(MODE==1&&qb>0){
    f32x16 g=f32x16{};
    const lds_fptr kmr=(lds_fptr)(shm3+LDS_KM)+(r32&15)*64+8*hi;
    #pragma unroll
    for(int d0=0;d0<4;++d0){
      const f32x4v x0=*(const __attribute__((address_space(3))) f32x4v*)(kmr+16*d0),x1=*(const __attribute__((address_space(3))) f32x4v*)(kmr+16*d0+4);
      u32x4 ah,al;
      ah[0]=cvtpk_s(x0[0],x0[1]);ah[1]=cvtpk_s(x0[2],x0[3]);ah[2]=cvtpk_s(x1[0],x1[1]);ah[3]=cvtpk_s(x1[2],x1[3]);
      al[0]=cvtpk_s(x0[0]-__uint_as_float(ah[0]<<16),x0[1]-__uint_as_float(ah[0]&0xffff0000u));
      al[1]=cvtpk_s(x0[2]-__uint_as_float(ah[1]<<16),x0[3]-__uint_as_float(ah[1]&0xffff0000u));
      al[2]=cvtpk_s(x1[0]-__uint_as_float(ah[2]<<16),x1[1]-__uint_as_float(ah[2]&0xffff0000u));
      al[3]=cvtpk_s(x1[2]-__uint_as_float(ah[3]<<16),x1[3]-__uint_as_float(ah[3]&0xffff0000u));
      g=MFMA32(__builtin_bit_cast(bf16x8,ah),qr[d0],g); g=MFMA32(__builtin_bit_cast(bf16x8,al),qr[d0],g);
    }
    float gv[16];
    #pragma unroll
    for(int r=0;r<8;++r){ const float mine=g[r]; auto sw=__builtin_amdgcn_permlane32_swap(__float_as_uint(mine),__float_as_uint(mine),false,false); const float oth=__uint_as_float(hi?sw[0]:sw[1]); const int n0=(r&3)+8*(r>>2); gv[n0]=hi?oth:mine; gv[n0+4]=hi?mine:oth; }
    #pragma unroll
    for(int pick=0;pick<3;++pick){ float best=-3.0e38f; int bi=-1;
      #pragma unroll
      for(int n=0;n<16;++n){ const bool ok=(n<qb)&&!((smask>>n)&1u); if(ok&&gv[n]>best){best=gv[n];bi=n;} }
      if(bi>=0)smask|=1u<<bi; }
  }
  u32x4 qaug=(u32x4){0u,0u,0u,0u}; u32x4 ka0=(u32x4){0u,0u,0u,0u},ka1=(u32x4){0u,0u,0u,0u};
  if(MODE==0){ unsigned h2; const unsigned h01=split3(fq_row-Bnd,h2); qaug[0]=hi?(0x3F80u|(h2<<16)):0x3F803F80u; qaug[1]=hi?0u:h01; ka0[1]=hi?0u:0x3F803F80u; ka1[1]=ka0[1]; ka0[0]=fau[0]; ka1[0]=fau[64]; }
  f32x16 cini=f32x16{};
  #define QAUG_MOBA(nb) do{ const float pen_=((smask>>(nb))&1u)?0.f:256.f; const float cv_=-(Bnd+pen_); _Pragma("unroll") for(int r_=0;r_<16;++r_)cini[r_]=cv_; asm volatile("":"+v"(cini)); }while(0)
  if(MODE==1)QAUG_MOBA(0);
  #define KA(x) __builtin_bit_cast(bf16x8,x)
  { const char*kb=Kbase+hi*1024+r32*16;
    if(MODE==0){ pA0=MFMA32(KA(ka0),KA(qaug),f32x16{}); pA1=MFMA32(KA(ka1),KA(qaug),f32x16{}); } else { pA0=cini; pA1=cini; }
    #pragma unroll
    for(int d0=0;d0<4;++d0){ const bf16x8 b0=*reinterpret_cast<const bf16x8*>(kb+d0*2048); const bf16x8 b1=*reinterpret_cast<const bf16x8*>(kb+d0*2048+512);
      pA0=MFMA32(b0,qr[d0],pA0); pA1=MFMA32(b1,qr[d0],pA1); } }
  BANDMASK(pA0,pA1,0);
  _Pragma("unroll") for(int r=0;r<16;++r){pA0[r]=__builtin_amdgcn_exp2f(pA0[r]);pA1[r]=__builtin_amdgcn_exp2f(pA1[r]);}
  WAIT_BAR(0);
  if(tid==0)misc[2]=nxt_;
  DMA_K(3,0);DMA_V(1,SLOTB);
  ROT();
  kload8(kf,kp0+sl_cur);
  if(MODE==0){ ka0[0]=fau[128]; ka1[0]=fau[128+64]; }
  WAIT_BAR(2);
  s16x4 vlo[8],vhi[8]; u32x4 pw0,pw1,pw2,pw3;
  #define PKW(P,B) cvtpk_s(P[B],P[B+1])
  #define PAF(k) __builtin_bit_cast(bf16x8,pw##k)
  #define VFR(i) (bf16x8){vlo[i][0],vlo[i][1],vlo[i][2],vlo[i][3],vhi[i][0],vhi[i][1],vhi[i][2],vhi[i][3]}
  #define PIN(x) asm volatile("":"+v"(x))
  #define GAPA(MF,A0,A1,A2,A3,W0,W1,PW) do{ MF; sacc+=A0; sacc+=A1; sacc+=A2; sacc+=A3; PIN(sacc); W0; W1; PIN(PW); SBAR(); }while(0)
  #define GAP0(MF) do{ MF; SBAR(); }while(0)
  #define EX(v) __builtin_amdgcn_exp2f(v)
  #define GAPB(MF,X,B) do{ MF; X[B]=EX(X[B]); X[B+1]=EX(X[B+1]); X[B+2]=EX(X[B+2]); X[B+3]=EX(X[B+3]); PIN(X); SBAR(); }while(0)
  #define VRD(i) do{ vlo[i]=vtr(vp_+(((i)>>2)*4096+((i)&3)*1024)); vhi[i]=vtr(vp_+(((i)>>2)*4096+((i)&3)*1024+512)); }while(0)
  #define KRD(G,j) do{ if(G){ kload2(kf,kp0+sl_next,j); SBAR(); } }while(0)
  #define KARD(G,t) do{ if(MODE==0&&(G)){ ka0[0]=fau[128*((t)+1)]; ka1[0]=fau[128*((t)+1)+64]; SBAR(); } }while(0)
  #define STEP(C0,C1,P0,P1,t,GK,GV,GL) do{ SBAR(); \
    const lds_cptr vp_=vp0+sl_prev; \
    if(GK){DMA_K((t)+3,sl_cur);} if(GV){DMA_V((t)+1,sl_next);} SBAR(); \
    if(MODE==1&&(((t)&3)==0)){ QAUG_MOBA((t)>>2); SBAR(); } \
    VRD(0); SBAR(); float sacc=(P0[0]+P0[1]); \
    if(MODE==0){ \
    GAPA(C0=MFMA32(KA(ka0),KA(qaug),f32x16{}), P0[2],P0[3],P0[4],P0[5],     pw0[0]=PKW(P0,0), pw0[1]=PKW(P0,2), pw0); \
    VRD(4); SBAR(); GAPA(C1=MFMA32(KA(ka1),KA(qaug),f32x16{}), P0[6],P0[7],P0[8],P0[9],     pw0[2]=PKW(P0,4), pw0[3]=PKW(P0,6), pw0); \
    VRD(1); SBAR(); GAPA(C0=MFMA32(kf[0],qr[0],C0),   P0[10],P0[11],P0[12],P0[13], pw1[0]=PKW(P0,8), pw1[1]=PKW(P0,10), pw1); \
    VRD(5); SBAR(); GAPA(C1=MFMA32(kf[1],qr[0],C1),   P0[14],P0[15],P1[0],P1[1],   pw1[2]=PKW(P0,12),pw1[3]=PKW(P0,14), pw1); \
    GAPA(C0=MFMA32(kf[2],qr[1],C0),   P1[2],P1[3],P1[4],P1[5],     pw2[0]=PKW(P1,0), pw2[1]=PKW(P1,2), pw2); \
    GAPA(C1=MFMA32(kf[3],qr[1],C1),   P1[6],P1[7],P1[8],P1[9],     pw2[2]=PKW(P1,4), pw2[3]=PKW(P1,6), pw2); \
    GAPA(C0=MFMA32(kf[4],qr[2],C0),   P1[10],P1[11],P1[12],P1[13], pw3[0]=PKW(P1,8), pw3[1]=PKW(P1,10), pw3); \
    GAPA(C1=MFMA32(kf[5],qr[2],C1),   P1[14],P1[15],0.f,0.f,       pw3[2]=PKW(P1,12),pw3[3]=PKW(P1,14), pw3); \
    GAP0(C0=MFMA32(kf[6],qr[3],C0)); GAP0(C1=MFMA32(kf[7],qr[3],C1)); \
    } else { \
    GAPA(C0=MFMA32(kf[0],qr[0],cini), P0[2],P0[3],P0[4],P0[5],     pw0[0]=PKW(P0,0), pw0[1]=PKW(P0,2), pw0); \
    VRD(4); SBAR(); GAPA(C1=MFMA32(kf[1],qr[0],cini), P0[6],P0[7],P0[8],P0[9],     pw0[2]=PKW(P0,4), pw0[3]=PKW(P0,6), pw0); \
    VRD(1); SBAR(); GAPA(C0=MFMA32(kf[2],qr[1],C0),   P0[10],P0[11],P0[12],P0[13], pw1[0]=PKW(P0,8), pw1[1]=PKW(P0,10), pw1); \
    VRD(5); SBAR(); GAPA(C1=MFMA32(kf[3],qr[1],C1),   P0[14],P0[15],P1[0],P1[1],   pw1[2]=PKW(P0,12),pw1[3]=PKW(P0,14), pw1); \
    GAPA(C0=MFMA32(kf[4],qr[2],C0),   P1[2],P1[3],P1[4],P1[5],     pw2[0]=PKW(P1,0), pw2[1]=PKW(P1,2), pw2); \
    GAPA(C1=MFMA32(kf[5],qr[2],C1),   P1[6],P1[7],P1[8],P1[9],     pw2[2]=PKW(P1,4), pw2[3]=PKW(P1,6), pw2); \
    GAPA(C0=MFMA32(kf[6],qr[3],C0),   P1[10],P1[11],P1[12],P1[13], pw3[0]=PKW(P1,8), pw3[1]=PKW(P1,10), pw3); \
    GAPA(C1=MFMA32(kf[7],qr[3],C1),   P1[14],P1[15],0.f,0.f,       pw3[2]=PKW(P1,12),pw3[3]=PKW(P1,14), pw3); \
    } \
    l_reg+=sacc; \
    BANDMASK(C0,C1,t); \
    SBAR(); \
    KARD(GL,t); VRD(2); VRD(6); SBAR(); GAPB(o[0]=MFMA32(PAF(0),VFR(0),o[0]), C0,0); \
    VRD(3); VRD(7); SBAR(); GAPB(o[1]=MFMA32(PAF(0),VFR(4),o[1]), C0,4); \
    KRD(GL,0); GAPB(o[0]=MFMA32(PAF(1),VFR(1),o[0]), C0,8); \
    KRD(GL,1); GAPB(o[1]=MFMA32(PAF(1),VFR(5),o[1]), C0,12); \
    KRD(GL,2); GAPB(o[0]=MFMA32(PAF(2),VFR(2),o[0]), C1,0); \
    KRD(GL,3); GAPB(o[1]=MFMA32(PAF(2),VFR(6),o[1]), C1,4); \
    GAPB(o[0]=MFMA32(PAF(3),VFR(3),o[0]), C1,8); \
    GAPB(o[1]=MFMA32(PAF(3),VFR(7),o[1]), C1,12); \
    }while(0)
  int t=1;
  #undef BANDMASK
  #define BANDMASK(P0,P1,t) do{}while(0)
  for(;t+7<NT;t+=2){
    STEP(pB0,pB1,pA0,pA1,t,true,true,true);     WAIT_BAR(2); ROT();
    STEP(pA0,pA1,pB0,pB1,t+1,true,true,true);   WAIT_BAR(2); ROT();
  }
  #undef BANDMASK
  #define BANDMASK(P0,P1,t) do{int jb_=(t)-(NT-4); if(MODE==1&&jb_>=-2&&(32*wid-64*jb_<176))bias_add(P0,P1,jb_,qrel,hi,tabp); if(jb_>=(wid>>1))cmask(P0,P1,jb_,qrel,hi); }while(0)
  #define ENDW(tt) do{ if((tt)+3<NT){WAIT_BAR(2);} else if((tt)+2<NT){WAIT_BAR(1);} else {WAIT_BAR(0);} }while(0)
  for(;t+3<NT;t+=2){
    STEP(pB0,pB1,pA0,pA1,t,(t+3<NT),(t+1<NT),(t+1<NT));       ENDW(t);   ROT();
    STEP(pA0,pA1,pB0,pB1,t+1,(t+4<NT),(t+2<NT),(t+2<NT));     ENDW(t+1); ROT();
  }
  #define STEP_PV(P0,P1,t,GK,GV) do{ SBAR(); const lds_cptr vp_=vp0+sl_prev; if(GK){DMA_K((t)+3,sl_cur);} if(GV){DMA_V((t)+1,sl_next);} SBAR(); \
    VRD(0);VRD(4);VRD(1);VRD(5); \
    { float sacc=P0[0]+P0[1]; _Pragma("unroll") for(int r_=2;r_<16;++r_)sacc+=P0[r_]; _Pragma("unroll") for(int r_=0;r_<16;++r_)sacc+=P1[r_]; l_reg+=sacc; } \
    pw0=(u32x4){PKW(P0,0),PKW(P0,2),PKW(P0,4),PKW(P0,6)};pw1=(u32x4){PKW(P0,8),PKW(P0,10),PKW(P0,12),PKW(P0,14)};pw2=(u32x4){PKW(P1,0),PKW(P1,2),PKW(P1,4),PKW(P1,6)};pw3=(u32x4){PKW(P1,8),PKW(P1,10),PKW(P1,12),PKW(P1,14)}; SBAR(); \
    VRD(2);VRD(6);VRD(3);VRD(7); \
    o[0]=MFMA32(PAF(0),VFR(0),o[0]); o[1]=MFMA32(PAF(0),VFR(4),o[1]); o[0]=MFMA32(PAF(1),VFR(1),o[0]); o[1]=MFMA32(PAF(1),VFR(5),o[1]); \
    o[0]=MFMA32(PAF(2),VFR(2),o[0]); o[1]=MFMA32(PAF(2),VFR(6),o[1]); o[0]=MFMA32(PAF(3),VFR(3),o[0]); o[1]=MFMA32(PAF(3),VFR(7),o[1]); SBAR(); }while(0)
  STEP(pB0,pB1,pA0,pA1,t,(t+3<NT),(t+1<NT),(t+1<NT));       ENDW(t);   ROT();
  const int nx_=__builtin_amdgcn_readfirstlane((int)misc[2]); const bool pre_next=nx_<128;
  if(LOWW>=0?(LOWW==1):(SKIP_MODES(MODE)&&wid<4)){
  STEP_PV(pB0,pB1,t+1,false,true); ENDW(t+1); ROT();
  if(pre_next){ const int qb2=15-(nx_>>3),h2=nx_&7; int T2=0; if(MODE==0)T2=__builtin_amdgcn_readfirstlane(((const __attribute__((address_space(3))) int*)(shm3+LDS_TAB))[h2*16+qb2]);
    const bf16*ks2=QKV+(rowbase+(long)(T2*KVBLK+lane))*QP+(MODE?1536:0)+h2*D+512+wid*8;
    glds16(ks2,(unsigned)__builtin_amdgcn_readfirstlane(kdst)); glds16(ks2+(long)KVBLK*QP,(unsigned)__builtin_amdgcn_readfirstlane(kdst+SLOTB)); glds16(ks2+(long)2*KVBLK*QP,(unsigned)__builtin_amdgcn_readfirstlane(kdst+2*SLOTB));
    if(MODE==0){ const int NT2=4*(qb2+1)-T2; const char*src2=(const char*)(Kaug+(size_t)(b*NHEAD+h2)*SEQ+KVBLK*T2)+lane*16;
      for(int pc=wid;pc<NT2/2;pc+=NW)glds16(src2+pc*1024,(unsigned)__builtin_amdgcn_readfirstlane(lds0+LDS_FAUG+KVBLK*T2*8+pc*1024)); } }
  }else{
  STEP(pA0,pA1,pB0,pB1,t+1,false,true,true); ENDW(t+1); ROT();
  if(pre_next){ const int qb2=15-(nx_>>3),h2=nx_&7; int T2=0; if(MODE==0)T2=__builtin_amdgcn_readfirstlane(((const __attribute__((address_space(3))) int*)(shm3+LDS_TAB))[h2*16+qb2]);
    const bf16*ks2=QKV+(rowbase+(long)(T2*KVBLK+lane))*QP+(MODE?1536:0)+h2*D+512+wid*8;
    glds16(ks2,(unsigned)__builtin_amdgcn_readfirstlane(kdst)); glds16(ks2+(long)KVBLK*QP,(unsigned)__builtin_amdgcn_readfirstlane(kdst+SLOTB)); glds16(ks2+(long)2*KVBLK*QP,(unsigned)__builtin_amdgcn_readfirstlane(kdst+2*SLOTB));
    if(MODE==0){ const int NT2=4*(qb2+1)-T2; const char*src2=(const char*)(Kaug+(size_t)(b*NHEAD+h2)*SEQ+KVBLK*T2)+lane*16;
      for(int pc=wid;pc<NT2/2;pc+=NW)glds16(src2+pc*1024,(unsigned)__builtin_amdgcn_readfirstlane(lds0+LDS_FAUG+KVBLK*T2*8+pc*1024)); } }
  STEP(pB0,pB1,pA0,pA1,NT-1,false,false,false);
  { float sacc=pB0[0]+pB0[1]; _Pragma("unroll") for(int r=2;r<16;++r)sacc+=pB0[r]; _Pragma("unroll") for(int r=0;r<16;++r)sacc+=pB1[r]; l_reg+=sacc;
    pw0=(u32x4){PKW(pB0,0),PKW(pB0,2),PKW(pB0,4),PKW(pB0,6)};pw1=(u32x4){PKW(pB0,8),PKW(pB0,10),PKW(pB0,12),PKW(pB0,14)};pw2=(u32x4){PKW(pB1,0),PKW(pB1,2),PKW(pB1,4),PKW(pB1,6)};pw3=(u32x4){PKW(pB1,8),PKW(pB1,10),PKW(pB1,12),PKW(pB1,14)};
    SBAR(); pv(o,vb0+sl_cur,PAF(0),PAF(1),PAF(2),PAF(3)); }
  }
  int tid_t=threadIdx.x; asm volatile("":"+v"(tid_t)); const int lane_t=tid_t&63,r32_t=lane_t&31,hi_t=lane_t>>5;
  int qb2_=0,h2_=0,T2_=0;
  _Pragma("unroll") for(int d0=0;d0<4;++d0)sm.q[d0]=(bf16x8){0,0,0,0,0,0,0,0}; sm.tabv=0.f; sm.km0=0.f; sm.km1=0.f; sm.r0=0.f; sm.r31=0.f; sm.fq=0.f; sm.base=basev;
  if(pre_next){ qb2_=15-(nx_>>3); h2_=nx_&7; if(MODE==0)T2_=__builtin_amdgcn_readfirstlane(((const __attribute__((address_space(3))) int*)(shm3+LDS_TAB))[h2_*16+qb2_]);
    const bf16*Qw2=QKV+(rowbase+(long)(qb2_*QB+wid*QBLK))*QP+(MODE?1536:0)+h2_*D;
    #pragma unroll
    for(int d0=0;d0<4;++d0)sm.q[d0]=__builtin_nontemporal_load(reinterpret_cast<const bf16x8*>(&Qw2[(long)r32_t*QP+d0*16+hi_t*8]));
    if(MODE==0){ sm.fq=Fl2[(size_t)(b*NHEAD+h2_)*SEQ+qb2_*QB+wid*QBLK+r32_t]; }
    else { const int bh2=b*NHEAD+h2_; sm.tabv=0.f; sm.r0=lane_t<32?relb[lane_t*8+h2_]:0.f; sm.r31=relb[31*8+h2_]; if(tid_t<113)sm.tabv=(relb[t5b[tid_t]*8+h2_]-relb[31*8+h2_])*1.4426950408889634f;
      const float*p0=kmp+((size_t)((bh2*16+(tid_t>>6))*2))*64+(tid_t&63); const float*p1=kmp+((size_t)((bh2*16+8+(tid_t>>6))*2))*64+(tid_t&63); sm.km0=p0[0]+p0[64]; sm.km1=p1[0]+p1[64]; } }
  #undef PKW
  #undef PAF
  #undef VFR
  #undef PIN
  #undef GAPA
  #undef GAP0
  #undef GAPB
  #undef EX
  #undef VRD
  #undef KRD
  #undef KARD
  #undef STEP
  #undef STEP_PV
  #undef ENDW
  #undef KA
  #undef QAUG_MOBA
  {auto rr=__builtin_amdgcn_permlane32_swap(__float_as_uint(l_reg),__float_as_uint(l_reg),false,false);l_reg=__uint_as_float(rr[0])+__uint_as_float(rr[1]);}
  if(hi_t==0)wsf[32+r32_t]=l_reg;asm volatile("s_waitcnt lgkmcnt(0)":::"memory");
  float rli[16];
  #pragma unroll
  for(int r=0;r<16;++r)rli[r]=__builtin_amdgcn_rcpf(wsf[32+crow(r,hi_t)]);
  bf16*Ow=O+(rowbase+q0+wid*QBLK)*OP+MODE*512+h*D;
  { bf16*stg=(bf16*)(shm+LDS_OST)+wid*2048;
    #pragma unroll
    for(int r=0;r<16;++r){const int orow=crow(r,hi_t);
      #pragma unroll
      for(int d0=0;d0<2;++d0)stg[orow*64+d0*32+r32_t]=__float2bfloat16(o[d0][r]*rli[r]);}
    asm volatile("s_waitcnt lgkmcnt(0)":::"memory");
    #pragma unroll
    for(int i=0;i<4;++i){const int row=i*8+(lane_t>>3),ch=lane_t&7; const u32x4 v=*(const u32x4*)(stg+row*64+ch*8); *(u32x4*)(Ow+(long)row*OP+ch*8)=v;} }
  if(tid_t==0)misc[0]=nxt_;
  asm volatile("s_waitcnt lgkmcnt(0)\n\ts_barrier":::"memory");
  const int next_unit=(int)misc[0];
  #undef DMA_K
  #undef DMA_V
  #undef BANDMASK
  #undef ROT
  return next_unit;
}
constexpr int ATTN_LDS_BYTES=LDS_BYTES;
#undef SBAR
#undef WAIT_BAR
#undef MFMA32
}

#define LAS __attribute__((address_space(3)))
typedef unsigned short bf16_t;
constexpr int NWAVES = 8, NTHREADS = 512;
constexpr int RING_BYTES = 131072, EXT_OFF = RING_BYTES + 256, LDS_BYTES = 150528;
#define LDS_WAIT() asm volatile("s_waitcnt lgkmcnt(0)" ::: "memory")
#ifndef P0B_W16
#define P0B_W16 1
#endif
#ifdef NT_P0
#define LDW(p) __builtin_nontemporal_load((const float*)(p))
#else
#define LDW(p) (*(const float*)(p))
#endif
#ifdef NT_X
#define LDX(p) __builtin_nontemporal_load((const f32x4*)(p))
#else
#define LDX(p) (*(const f32x4*)(p))
#endif

struct Params { const float* in[17]; float* out; unsigned char* ws; };

#define XB_TMO      128
#define XB_XCNT(j)  (256  + 64 * (j))
#define XB_XSUB(j)  (1280 + 64 * (j))
#define XB_XGEN(j)  (2304 + 64 * (j))
#define XB_TOP      3328
#define XB_TOPGEN   3392
#define XCD_BAR_WORDS 3456
#define XB_SPIN_CAP (1u << 18)

__device__ __forceinline__ unsigned xb_ld(unsigned* p)              { return __hip_atomic_load(p, __ATOMIC_RELAXED, __HIP_MEMORY_SCOPE_AGENT); }
__device__ __forceinline__ unsigned xb_add(unsigned* p, unsigned v) { return __hip_atomic_fetch_add(p, v, __ATOMIC_RELAXED, __HIP_MEMORY_SCOPE_AGENT); }
__device__ __forceinline__ unsigned xb_xcc_id() { return (unsigned)__builtin_amdgcn_s_getreg((3 << 11) | 20) & 0xFu; }
#define XB_SPIN(cond, bar) do { unsigned _sp = 0; while (cond) { __builtin_amdgcn_s_sleep(1); \
    if ((++_sp & 255u) == 0u) { if (xb_ld(&(bar)[XB_TMO])) break; if (_sp > XB_SPIN_CAP) { atomicAdd(&(bar)[XB_TMO], 1u); break; } } } } while (0)

struct XcdBarrier {
    unsigned* bar; unsigned x;
    volatile LAS unsigned* st;
};

__device__ __forceinline__ XcdBarrier xcd_barrier_post(unsigned* bar, volatile LAS unsigned* st) {
    XcdBarrier b; b.bar = bar; b.x = xb_xcc_id(); b.st = st;
    if (threadIdx.x == 0) (void)xb_add(&bar[XB_XCNT(b.x)], 1u);
    return b;
}
__device__ __forceinline__ void xcd_barrier_complete(unsigned* bar, unsigned x, unsigned& nloc, unsigned& nx) {
    const unsigned G = gridDim.x * gridDim.y * gridDim.z;
    unsigned sum, cnt, mine, sp = 0u;
    for (;;) {
        sum = 0u; cnt = 0u; mine = 0u;
#pragma unroll
        for (unsigned j = 0; j < 16; ++j) { const unsigned c = xb_ld(&bar[XB_XCNT(j)]); sum += c; cnt += (c > 0u) ? 1u : 0u; mine = (j == x) ? c : mine; }
        if (sum == G) break;
        __builtin_amdgcn_s_sleep(1);
        if ((++sp & 255u) == 0u) { if (xb_ld(&bar[XB_TMO])) break; if (sp > XB_SPIN_CAP) { atomicAdd(&bar[XB_TMO], 1u); break; } }
    }
    nloc = mine > 0u ? mine : 1u; nx = cnt > 0u ? cnt : 1u;
}

__device__ __forceinline__ void xcd_barrier(const XcdBarrier& b) {
    asm volatile("s_waitcnt vmcnt(0)" ::: "memory");
    __syncthreads();
    if (threadIdx.x == 0) {
        unsigned* bar = b.bar;
        __builtin_amdgcn_s_waitcnt(0);
        unsigned nloc = b.st[0], nx = b.st[1];
        if (nloc == 0u) { xcd_barrier_complete(bar, b.x, nloc, nx); b.st[0] = nloc; b.st[1] = nx; }
        const unsigned old = xb_add(&bar[XB_XSUB(b.x)], 1u);
        const unsigned gen = old / nloc;
        if (old + 1u == (gen + 1u) * nloc) {
            __builtin_amdgcn_fence(__ATOMIC_RELEASE, "agent");
            asm volatile("s_waitcnt vmcnt(0)" ::: "memory");
            const unsigned og = xb_add(&bar[XB_TOP], 1u);
            const unsigned tg = og / nx;
            if (og + 1u == (tg + 1u) * nx) xb_add(&bar[XB_TOPGEN], 1u);
            else XB_SPIN(xb_ld(&bar[XB_TOPGEN]) == tg, bar);
            __builtin_amdgcn_fence(__ATOMIC_ACQUIRE, "agent");
            xb_add(&bar[XB_XGEN(b.x)], 1u);
            asm volatile("s_waitcnt vmcnt(0)" ::: "memory");
        } else {
            XB_SPIN(xb_ld(&bar[XB_XGEN(b.x)]) == gen, bar);
            __builtin_amdgcn_fence(__ATOMIC_ACQUIRE, "agent");
            asm volatile("s_waitcnt vmcnt(0)" ::: "memory");
        }
    }
    __syncthreads();
}


__device__ __forceinline__ void tr_item(const float* __restrict__ W, int Nsrc, int K, int k0, int nsrc0, bf16_t* __restrict__ WT, int nout0, LAS float* scr, int lane) {
    float wv_[32];
#pragma unroll
    for (int i = 0; i < 32; ++i) wv_[i] = LDW(W + (size_t)(k0 + 2 * i + (lane >> 5)) * Nsrc + nsrc0 + (lane & 31));
#pragma unroll
    for (int i = 0; i < 32; ++i) scr[(2 * i + (lane >> 5)) * 33 + (lane & 31)] = wv_[i];
    LDS_WAIT(); asm volatile("" ::: "memory");
    const int c = lane & 7;
#pragma unroll
    for (int j = 0; j < 4; ++j) { const int n = (lane >> 3) + 8 * j; const LAS float* s = scr + (8 * c) * 33 + n;
        u32x4 o; o.x = pk2(s[0 * 33], s[1 * 33]); o.y = pk2(s[2 * 33], s[3 * 33]); o.z = pk2(s[4 * 33], s[5 * 33]); o.w = pk2(s[6 * 33], s[7 * 33]);
        *(u32x4*)(WT + (size_t)(nout0 + n) * K + k0 + 8 * c) = o; }
    LDS_WAIT(); asm volatile("" ::: "memory");
}
__device__ __forceinline__ void p0_weights(const Params& p, LAS unsigned char* lds, int gw, int ngw, int wave, int lane) {
    LAS float* scr = (LAS float*)(lds + wave * 16384);
    bf16_t* Wt_in = (bf16_t*)(p.ws + WS_WIN); bf16_t* Wt_o = (bf16_t*)(p.ws + WS_WO); bf16_t* Wt_gu = (bf16_t*)(p.ws + WS_WGU); bf16_t* Wt_dn = (bf16_t*)(p.ws + WS_WDN);
    constexpr int I_IN = 16 * 96, I_O = 16 * 32, I_GU = 16 * 176, I_DN = 44 * 32, NIT = I_IN + I_O + I_GU + I_DN;
    for (int it = gw; it < NIT; it += ngw) {
        int r = it;
        if (r < I_IN) { const int kb = r / 96, nb = r % 96, L0 = 32 * nb, pn = L0 >> 8, bj = (L0 >> 7) & 1, wc = (L0 >> 5) & 3, sec = pn >> 1, head = 4 * (pn & 1) + wc;
            const int src = 512 * sec + (sec >= 3 ? 8 : 0) + 64 * head + 32 * bj;
            tr_item(p.in[6], INC, DM, 64 * kb, src, Wt_in, L0, scr, lane); continue; }
        r -= I_IN;
        if (r < I_O) { const int kb = r / 32, nb = r % 32; tr_item(p.in[13], DM, DM, 64 * kb, 32 * nb, Wt_o, 32 * nb, scr, lane); continue; }
        r -= I_O;
        if (r < I_GU) { const int kb = r / 176, nb = r % 176, L0 = 32 * nb, pn = L0 >> 8, bj = (L0 >> 7) & 1, j0 = L0 & 127;
            tr_item(bj ? p.in[15] : p.in[14], DFF, DM, 64 * kb, 128 * pn + j0, Wt_gu, L0, scr, lane); continue; }
        r -= I_GU;
        { const int kb = r / 32, nb = r % 32; tr_item(p.in[16], DM, DFF, 64 * kb, 32 * nb, Wt_dn, 32 * nb, scr, lane); }
    }
}
__device__ __forceinline__ void p0_mod(const Params& p, LAS unsigned char* lds, int tid, int wave, int lane) {
    LAS float* sc = (LAS float*)lds; LAS float* red = (LAS float*)(lds + 32768);
    const float* c = p.in[1]; const float* w_ada = p.in[2]; const float* b_ada = p.in[3]; float* mod = (float*)(p.ws + WS_MOD);
    for (int i = tid; i < 8192; i += NTHREADS) { const float v = c[i]; sc[i] = v / (1.f + expf(-v)); }
    __syncthreads();
    const int col = blockIdx.x * 64 + lane;
    float a0 = 0, a1 = 0, a2 = 0, a3 = 0, a4 = 0, a5 = 0, a6 = 0, a7 = 0;
#pragma unroll 1
    for (int kb = wave * 128; kb < wave * 128 + 128; kb += 16) {
        float wv_[16];
#pragma unroll
        for (int i = 0; i < 16; ++i) wv_[i] = LDW(w_ada + (size_t)(kb + i) * 6144 + col);
#pragma unroll
        for (int i = 0; i < 16; ++i) { const float w = wv_[i]; const int k = kb + i;
            a0 += sc[k] * w; a1 += sc[1024 + k] * w; a2 += sc[2048 + k] * w; a3 += sc[3072 + k] * w;
            a4 += sc[4096 + k] * w; a5 += sc[5120 + k] * w; a6 += sc[6144 + k] * w; a7 += sc[7168 + k] * w;
            if ((i & 3) == 3) asm volatile("" ::: "memory"); }
    }
    LAS float* rw = red + wave * 512 + lane;
    rw[0] = a0; rw[64] = a1; rw[128] = a2; rw[192] = a3; rw[256] = a4; rw[320] = a5; rw[384] = a6; rw[448] = a7;
    __syncthreads();
    { const int b = tid >> 6; float s = 0.f;
#pragma unroll
      for (int w = 0; w < 8; ++w) s += red[w * 512 + b * 64 + lane];
      mod[b * 6144 + col] = s + b_ada[col]; }
    __syncthreads();
}
__device__ __forceinline__ float red8(const float (&ff)[8], int lane) {
    const bool b0 = (lane & 1) != 0, b1 = (lane & 2) != 0, b2 = (lane & 4) != 0;
    float t[4], u[2];
#pragma unroll
    for (int k = 0; k < 4; ++k) { const float a = b0 ? ff[2 * k + 1] : ff[2 * k], o = b0 ? ff[2 * k] : ff[2 * k + 1]; t[k] = a + lx1(o); }
#pragma unroll
    for (int k = 0; k < 2; ++k) { const float a = b1 ? t[2 * k + 1] : t[2 * k], o = b1 ? t[2 * k] : t[2 * k + 1]; u[k] = a + lx2(o); }
    float w = (b2 ? u[1] : u[0]) + lx4(b2 ? u[0] : u[1], b2);
    w += lx8(w); w = addx16(w); w = addx32(w);
    return w;
}
#if P0B_W16
#define KIDX(j) (512 * ((j) >> 1) + 8 * lane + 4 * ((j) & 1))
#else
#define KIDX(j) (256 * (j) + 4 * lane)
#endif
__device__ __forceinline__ void p0b_rows(const Params& p, LAS unsigned char* lds, int tid, int gw, int ngw, int lane) {
    const float* x = p.in[0]; const float* mod = (const float*)(p.ws + WS_MOD); const float* gain = p.in[4]; const float* w_in = p.in[6]; const float* b_forget = p.in[7];
    bf16_t* XN = (bf16_t*)(p.ws + WS_XN); float* logf = (float*)(p.ws + WS_LOGF);
    LAS float* wf = (LAS float*)lds;
    for (int i = tid; i < 8192; i += NTHREADS) { const int k = i >> 3, h = i & 7; wf[h * 1024 + k] = w_in[(size_t)k * INC + 1536 + h]; }
    __syncthreads();
    const float bfv = b_forget[lane & 7];
    const int RPW = MROWS / ngw;
#pragma unroll 1
    for (int rbase = gw * RPW; rbase < MROWS; rbase += ngw * RPW) {
        const int b = rbase >> 12;
        const float* shift = mod + b * 6144; const float* scale = shift + 1024;
        f32x4 gs[4], sh[4];
#pragma unroll
        for (int j = 0; j < 4; ++j) { const int k = KIDX(j); gs[j] = *(const f32x4*)(gain + k) * (*(const f32x4*)(scale + k) + 1.0f); sh[j] = *(const f32x4*)(shift + k); }
        asm volatile("" ::: "memory");
        f32x4 c0[4], c1[4], n0[4], n1[4];
#pragma unroll
        for (int j = 0; j < 4; ++j) { c0[j] = LDX(x + (size_t)rbase * DM + KIDX(j)); c1[j] = LDX(x + (size_t)(rbase + 1) * DM + KIDX(j)); }
#pragma unroll 1
        for (int i = 0; i < RPW; i += 2) {
            const int r0 = rbase + i, r1 = r0 + 1;
            if (i + 2 < RPW) {
#pragma unroll
                for (int j = 0; j < 4; ++j) { n0[j] = LDX(x + (size_t)(r0 + 2) * DM + KIDX(j)); n1[j] = LDX(x + (size_t)(r0 + 3) * DM + KIDX(j)); }
            }
            typedef float f32x2s_ __attribute__((ext_vector_type(2)));
            f32x2s_ q0a = {0.f, 0.f}, q0b = {0.f, 0.f}, q1a = {0.f, 0.f}, q1b = {0.f, 0.f};
#pragma unroll
            for (int j = 0; j < 4; ++j) { const f32x2s_ a0 = {c0[j][0], c0[j][1]}, b0 = {c0[j][2], c0[j][3]}, a1 = {c1[j][0], c1[j][1]}, b1 = {c1[j][2], c1[j][3]};
                q0a = __builtin_elementwise_fma(a0, a0, q0a); q0b = __builtin_elementwise_fma(b0, b0, q0b); q1a = __builtin_elementwise_fma(a1, a1, q1a); q1b = __builtin_elementwise_fma(b1, b1, q1b); }
            float s0 = (q0a.x + q0a.y) + (q0b.x + q0b.y), s1 = (q1a.x + q1a.y) + (q1b.x + q1b.y);
            s0 = wave_sum(s0); s1 = wave_sum(s1);
            const float rs0 = __builtin_amdgcn_rsqf(s0 * (1.0f / DM) + EPS), rs1 = __builtin_amdgcn_rsqf(s1 * (1.0f / DM) + EPS);
            typedef float f32x2_ __attribute__((ext_vector_type(2)));
            f32x2_ g0[8], g1[8]; u32x2 wp0 = {0u, 0u}, wp1 = {0u, 0u};
#pragma unroll
            for (int hh = 0; hh < 8; ++hh) { g0[hh] = (f32x2_){0.f, 0.f}; g1[hh] = (f32x2_){0.f, 0.f}; }
#pragma unroll
            for (int j = 0; j < 4; ++j) {
                const int k = KIDX(j);
                const f32x4 h0 = (c0[j] * rs0) * gs[j] + sh[j], h1 = (c1[j] * rs1) * gs[j] + sh[j];
                u32x2 w0, w1; w0.x = pg8::cvt_pk_bf16(h0[0], h0[1]); w0.y = pg8::cvt_pk_bf16(h0[2], h0[3]); w1.x = pg8::cvt_pk_bf16(h1[0], h1[1]); w1.y = pg8::cvt_pk_bf16(h1[2], h1[3]);
#if P0B_W16
                if (j & 1) { u32x4 q0, q1; q0.x = wp0.x; q0.y = wp0.y; q0.z = w0.x; q0.w = w0.y; q1.x = wp1.x; q1.y = wp1.y; q1.z = w1.x; q1.w = w1.y;
                    *(u32x4*)(XN + (size_t)r0 * DM + k - 4) = q0; *(u32x4*)(XN + (size_t)r1 * DM + k - 4) = q1; }
                else { wp0 = w0; wp1 = w1; }
#else
                *(u32x2*)(XN + (size_t)r0 * DM + k) = w0; *(u32x2*)(XN + (size_t)r1 * DM + k) = w1;
#endif
                f32x4 wv[8];
#pragma unroll
                for (int hh = 0; hh < 8; ++hh) wv[hh] = *(const LAS f32x4*)(wf + hh * 1024 + k);
                asm volatile("" ::: "memory");
#pragma unroll
                for (int hh = 0; hh < 8; ++hh) { const f32x2_ wa = {wv[hh][0], wv[hh][1]}, wb = {wv[hh][2], wv[hh][3]};
                    g0[hh] = __builtin_elementwise_fma((f32x2_){h0[0], h0[1]}, wa, g0[hh]); g1[hh] = __builtin_elementwise_fma((f32x2_){h1[0], h1[1]}, wa, g1[hh]);
                    g0[hh] = __builtin_elementwise_fma((f32x2_){h0[2], h0[3]}, wb, g0[hh]); g1[hh] = __builtin_elementwise_fma((f32x2_){h1[2], h1[3]}, wb, g1[hh]); }
            }
            float f0[8], f1[8];
#pragma unroll
            for (int hh = 0; hh < 8; ++hh) { f0[hh] = g0[hh].x + g0[hh].y; f1[hh] = g1[hh].x + g1[hh].y; }
            const float z0 = red8(f0, lane) + bfv, z1 = red8(f1, lane) + bfv;
            if (lane < 8) {
                float* lf = logf + ((size_t)(b * 8 + lane)) * SEQ + (r0 & 4095);
                lf[0] = fminf(z0, 0.f) - log1pf(expf(-fabsf(z0)));
                lf[1] = fminf(z1, 0.f) - log1pf(expf(-fabsf(z1)));
            }
#pragma unroll
            for (int j = 0; j < 4; ++j) { c0[j] = n0[j]; c1[j] = n1[j]; }
        }
    }
}
#undef KIDX
__device__ __forceinline__ void p0b_c2(const Params& p, LAS unsigned char* lds, int tid, int gw, int ngw, int lane) {
    const float* mod = (const float*)(p.ws + WS_MOD); const bf16_t* Wgu = (const bf16_t*)(p.ws + WS_WGU); float* c2 = (float*)(p.ws + WS_C2);
    LAS float* s2 = (LAS float*)(lds + 32768);
    for (int i = tid; i < 8192; i += NTHREADS) s2[i] = mod[(i >> 10) * 6144 + 3 * 1024 + (i & 1023)];
    __syncthreads();
#pragma unroll 1
    for (int n = gw; n < NGU; n += ngw) {
        const u32x4 w0 = *(const u32x4*)(Wgu + (size_t)n * DM + 16 * lane), w1 = *(const u32x4*)(Wgu + (size_t)n * DM + 16 * lane + 8);
        const float wv[16] = {bf2f(w0.x & 0xffffu), bf2f(w0.x >> 16), bf2f(w0.y & 0xffffu), bf2f(w0.y >> 16), bf2f(w0.z & 0xffffu), bf2f(w0.z >> 16), bf2f(w0.w & 0xffffu), bf2f(w0.w >> 16),
                              bf2f(w1.x & 0xffffu), bf2f(w1.x >> 16), bf2f(w1.y & 0xffffu), bf2f(w1.y >> 16), bf2f(w1.z & 0xffffu), bf2f(w1.z >> 16), bf2f(w1.w & 0xffffu), bf2f(w1.w >> 16)};
        float a[8];
#pragma unroll
        for (int b = 0; b < 8; ++b) {
            const LAS float* sh = s2 + b * 1024 + 16 * lane; float t = 0.f;
#pragma unroll
            for (int q4 = 0; q4 < 4; ++q4) { const f32x4 s4 = *(const LAS f32x4*)(sh + 4 * q4); t += (s4[0] * wv[4 * q4] + s4[1] * wv[4 * q4 + 1]) + (s4[2] * wv[4 * q4 + 2] + s4[3] * wv[4 * q4 + 3]); }
            a[b] = t;
        }
        const float r = red8(a, lane);
        if (lane < 8) c2[lane * NGU + n] = r;
    }
}
#ifndef FOX_SKIP_BITS
#define FOX_SKIP_BITS 40
#endif
__device__ __forceinline__ void p1_scan(const Params& p, LAS unsigned char* lds, int tid) {
    LAS double* part = (LAS double*)lds;
    const float* src = (const float*)(p.ws + WS_LOGF) + (size_t)blockIdx.x * SEQ + tid * 8;
    double run = 0.0; double loc[8];
#pragma unroll
    for (int i = 0; i < 8; ++i) { run += (double)src[i]; loc[i] = run; }
    double inc = run;
#pragma unroll
    for (int o = 1; o < 64; o <<= 1) { const double up = __shfl_up(inc, o); if ((tid & 63) >= o) inc += up; }
    if ((tid & 63) == 63) part[tid >> 6] = inc;
    __syncthreads();
    double off = inc - run;
    for (int w = 0; w < (tid >> 6); ++w) off += part[w];
    float* dst = (float*)(p.ws + WS_FL2) + (size_t)blockIdx.x * SEQ + tid * 8;
    u32x2* ka = (u32x2*)(p.ws + WS_KAUG) + (size_t)blockIdx.x * SEQ + tid * 8;
#pragma unroll
    for (int i = 0; i < 8; ++i) {
        const double v = -(off + loc[i]) * 1.4426950408889634;
        dst[i] = (float)(-v);
        const unsigned h0 = f2bf((float)v); const double r1 = v - (double)bf2f(h0);
        const unsigned h1 = f2bf((float)r1); const double r2 = r1 - (double)bf2f(h1);
        const unsigned h2 = f2bf((float)r2);
        u32x2 w; w.x = h0 | (h1 << 16); w.y = h2 | 0x3F800000u; ka[i] = w;
    }
    float thr = 152.0f;
    if (tid < 64) { const float* gt = (const float*)(p.ws + WS_GT); const float gq = fabsf(gt[tid]), gk = fabsf(gt[64 + tid]);
        const float Bq = 64.f * attn_body::wmax(gq) * attn_body::wmax(gk) * (0.125f * 1.4426950408889634f) * 1.02f + 0.25f; thr = fminf(152.0f, 2.0f * Bq + (float)FOX_SKIP_BITS); }
    __syncthreads();
    LAS float* tend = (LAS float*)(lds + 8192); LAS float* fq0 = tend + 64;
    if ((tid & 7) == 7) tend[tid >> 3] = (float)((off + loc[7]) * 1.4426950408889634);
    if ((tid & 31) == 0) fq0[tid >> 5] = (float)((off + loc[0]) * 1.4426950408889634);
    __syncthreads();
    if (tid < 16) { int cnt = 0; const float f0 = fq0[tid]; for (int t = 0; t < 4 * tid; ++t) cnt += (tend[t] - f0 > thr) ? 1 : 0; ((int*)(p.ws + WS_T0))[blockIdx.x * 16 + tid] = cnt & ~1; }
    __syncthreads();
}

#ifndef REP_P0
#define REP_P0 1
#endif
#ifndef REP_P0B
#define REP_P0B 1
#endif
#ifndef REP_P1
#define REP_P1 1
#endif
#ifndef REP_P2
#define REP_P2 1
#endif
#ifndef REP_P3
#define REP_P3 1
#endif
#ifndef REP_P4
#define REP_P4 1
#endif
constexpr int CTL_MODCNT = 3584, CTL_SCANCNT = 3648;
__device__ __forceinline__ void flag_arrive(unsigned* cnt) {
    asm volatile("s_waitcnt vmcnt(0)" ::: "memory");
    __syncthreads();
    if (threadIdx.x == 0) { __builtin_amdgcn_fence(__ATOMIC_RELEASE, "agent"); asm volatile("s_waitcnt vmcnt(0)" ::: "memory"); (void)xb_add(cnt, 1u); }
}
__device__ __forceinline__ void flag_wait(unsigned* cnt, unsigned need, unsigned* bar) {
    if (threadIdx.x == 0) { XB_SPIN(xb_ld(cnt) < need, bar); __builtin_amdgcn_fence(__ATOMIC_ACQUIRE, "agent"); asm volatile("s_waitcnt vmcnt(0)" ::: "memory"); }
    __syncthreads();
}
__global__ void __launch_bounds__(NTHREADS, 2) mega_fwd(Params p) {
    extern __shared__ __attribute__((aligned(16))) unsigned char lds[];
    LAS unsigned char* L = (LAS unsigned char*)lds;
    const int tid = threadIdx.x, lane = tid & 63, wave = __builtin_amdgcn_readfirstlane(tid >> 6);
    const int G = gridDim.x, gw = blockIdx.x * NWAVES + wave, ngw = G * NWAVES;
    unsigned char* ws = p.ws;
    volatile LAS unsigned* MISC = (volatile LAS unsigned*)(L + RING_BYTES);
    if (tid < 16) MISC[tid] = 0u;
    __syncthreads();
    XcdBarrier xbar = xcd_barrier_post((unsigned*)(ws + WS_CTL), MISC + 8);
#define GRID_BAR() xcd_barrier(xbar)
    const bf16_t* Wt_in = (const bf16_t*)(ws + WS_WIN); const bf16_t* Wt_o = (const bf16_t*)(ws + WS_WO); const bf16_t* Wt_gu = (const bf16_t*)(ws + WS_WGU); const bf16_t* Wt_dn = (const bf16_t*)(ws + WS_WDN);
    bf16_t* XN = (bf16_t*)(ws + WS_XN); bf16_t* QKV = (bf16_t*)(ws + WS_QKV); bf16_t* Hb = (bf16_t*)(ws + WS_H); bf16_t* ATT = (bf16_t*)(ws + WS_ATT);
    float* mod = (float*)(ws + WS_MOD); float* c2 = (float*)(ws + WS_C2); float* kmp = (float*)(ws + WS_KMP); float* rsq = (float*)(ws + WS_RSQ);

#ifdef EXTRA_SYNC
    for (int rep_ = 0; rep_ < EXTRA_SYNC; ++rep_) GRID_BAR();
#endif
    if ((int)blockIdx.x == G - 1 && tid < 256) ((float*)(ws + WS_GT))[tid] = p.in[8 + (tid >> 6)][tid & 63];
    if (G > 128) { if (blockIdx.x < 96) p0_mod(p, L, tid, wave, lane); else p0_weights(p, L, (blockIdx.x - 96) * NWAVES + wave, (G - 96) * NWAVES, wave, lane); }
    else { if (blockIdx.x < 96) p0_mod(p, L, tid, wave, lane); p0_weights(p, L, gw, ngw, wave, lane); }
    GRID_BAR();
    p0b_rows(p, L, tid, gw, ngw, lane);
    p0b_c2(p, L, tid, gw, ngw, lane);
    GRID_BAR();
#ifndef NO_P1
    for (int rep_ = 0; rep_ < REP_P1; ++rep_) {
    {
        pg8::Gemm g{XN, Wt_in, MROWS, NQKV, DM}; pg8::StaticOrder S; S.init(MROWS, NQKV, G, (int)blockIdx.x);
        pg8::EpiInProj E{QKV, (const float*)(ws + WS_GT), kmp};
        pg8::gemm_phase<pg8::EpiInProj, pg8::StaticOrder, true, true>(L, g, S, E);
    }
    if (rep_ + 1 < REP_P1) GRID_BAR(); }
#endif
    GRID_BAR();
#ifndef NO_P2
    for (int rep_ = 0; rep_ < REP_P2; ++rep_) {
    {
        const int vcu = (G % 8 == 0) ? (int)(blockIdx.x % 8) * (G / 8) + (int)(blockIdx.x / 8) : (int)blockIdx.x;
        const int xg = (vcu * 8) / G;
        const attn_body::bf16* qkv = (const attn_body::bf16*)QKV; attn_body::bf16* att = (attn_body::bf16*)ATT;
        const attn_body::u32x2v* kaug = (const attn_body::u32x2v*)(ws + WS_KAUG); const float* fl2 = (const float*)(ws + WS_FL2); const float* gt = (const float*)(ws + WS_GT);
        const int* t0tab = (const int*)(ws + WS_T0);
        if (rep_ == 0 && blockIdx.x < 64) { p1_scan(p, L, tid); flag_arrive((unsigned*)(ws + WS_CTL) + CTL_SCANCNT); }
        {
            unsigned* ctr = (unsigned*)(ws + WS_CTL) + 4096 + 64 * (8 + xg) + 1024 * rep_;
            if (tid == 0) MISC[0] = __hip_atomic_fetch_add(ctr, 1u, __ATOMIC_RELAXED, __HIP_MEMORY_SCOPE_AGENT);
            __syncthreads();
            int cur = (int)MISC[0];
            int pre = 0; attn_body::Seam sm;
#pragma unroll 1
            while (cur < 128) { const int qb = 15 - (cur >> 3), bh = 8 * xg + (cur & 7);
                cur = attn_body::attn_unit<1>(bh >> 3, bh & 7, qb, 0, qkv, kaug, fl2, kmp, p.in[12], gt, T5B, att, (char*)lds, ctr, MISC, pre, t0tab, sm); pre = 1; }
        }
        __syncthreads();
        {
            unsigned* ctr = (unsigned*)(ws + WS_CTL) + 4096 + 64 * xg + 1024 * rep_;
            flag_wait((unsigned*)(ws + WS_CTL) + CTL_SCANCNT, 64u, (unsigned*)(ws + WS_CTL));
            if (tid == 0) MISC[0] = __hip_atomic_fetch_add(ctr, 1u, __ATOMIC_RELAXED, __HIP_MEMORY_SCOPE_AGENT);
            __syncthreads();
            int cur = (int)MISC[0];
            int pre = 0; attn_body::Seam sm;
            if (tid < 128) ((LAS int*)(L + attn_body::LDS_TAB))[tid] = t0tab[xg * 128 + tid];
            __syncthreads();
#pragma unroll 1
            while (cur < 128) { const int qb = 15 - (cur >> 3), bh = 8 * xg + (cur & 7);
                const int T0 = __builtin_amdgcn_readfirstlane(((const LAS int*)(L + attn_body::LDS_TAB))[(cur & 7) * 16 + qb]);
                if (wave < 4) cur = attn_body::attn_unit<0, 1>(bh >> 3, bh & 7, qb, T0, qkv, kaug, fl2, kmp, p.in[12], gt, T5B, att, (char*)lds, ctr, MISC, pre, t0tab, sm);
                else          cur = attn_body::attn_unit<0, 0>(bh >> 3, bh & 7, qb, T0, qkv, kaug, fl2, kmp, p.in[12], gt, T5B, att, (char*)lds, ctr, MISC, pre, t0tab, sm);
                pre = 1; }
        }
    }
    if (rep_ + 1 < REP_P2) GRID_BAR(); }
#endif
    GRID_BAR();
#ifndef NO_P3
    for (int rep_ = 0; rep_ < REP_P3; ++rep_) {
    {
        pg8::Gemm g{ATT, Wt_o, MROWS, DM, DM}; pg8::StaticOrder S; S.init(MROWS, DM, G, (int)blockIdx.x);
        pg8::EpiWo E{p.in[0], p.out, XN, mod, p.in[5], rsq, (bf16_t*)(ws + WS_X1B)};
        pg8::gemm_phase<pg8::EpiWo, pg8::StaticOrder, true, true>(L, g, S, E);
    }
    if (rep_ + 1 < REP_P3) GRID_BAR(); }
#endif
    GRID_BAR();
#ifndef NO_P4
    for (int rep_ = 0; rep_ < REP_P4; ++rep_) {
    {
        pg8::Gemm g{XN, Wt_gu, MROWS, NGU, DM}; pg8::StaticOrder S; S.init(MROWS, NGU, G, (int)blockIdx.x);
        pg8::EpiSwiGLU E{Hb, c2, rsq, L + EXT_OFF};
        pg8::gemm_phase<pg8::EpiSwiGLU, pg8::StaticOrder, true, true>(L, g, S, E);
    }
    if (rep_ + 1 < REP_P4) GRID_BAR(); }
#endif
    GRID_BAR();
#ifndef NO_P5
#ifdef REP_P5
    {
        pg8::Gemm g{Hb, Wt_dn, MROWS, DM, DFF}; pg8::StaticOrder S; S.init(MROWS, DM, G, (int)blockIdx.x);
        pg8::EpiDown E{p.out, (float*)(ws + 384 * MiB), mod, (const bf16_t*)(ws + WS_X1B)};
        pg8::gemm_phase<pg8::EpiDown, pg8::StaticOrder, true, true>(L, g, S, E);
    }
    GRID_BAR();
#endif
    {
        pg8::Gemm g{Hb, Wt_dn, MROWS, DM, DFF}; pg8::StaticOrder S; S.init(MROWS, DM, G, (int)blockIdx.x);
        pg8::EpiDown E{p.out, p.out, mod, (const bf16_t*)(ws + WS_X1B)};
        pg8::gemm_phase<pg8::EpiDown, pg8::StaticOrder, true, true>(L, g, S, E);
    }
#endif
}

extern "C" void kernel_launch(void* const* d_in, const int* in_sizes, int n_in, void* d_out, int out_size, void* d_ws, size_t ws_size, hipStream_t stream) {
    static int grid = 0;
    if (grid == 0) {
        int dev = 0, cus = 0, per_cu = 0;
        hipGetDevice(&dev);
        hipDeviceGetAttribute(&cus, hipDeviceAttributeMultiprocessorCount, dev);
        hipFuncSetAttribute((const void*)mega_fwd, hipFuncAttributeMaxDynamicSharedMemorySize, LDS_BYTES);
        hipOccupancyMaxActiveBlocksPerMultiprocessor(&per_cu, (const void*)mega_fwd, NTHREADS, LDS_BYTES);
        if (per_cu < 1) { fprintf(stderr, "kernel_launch: occupancy query says %d blocks/CU\n", per_cu); per_cu = 1; }
        if (per_cu > 1) per_cu = 1;
        grid = cus * per_cu;
        if (n_in != 17 || ws_size < WS_END) fprintf(stderr, "kernel_launch: unexpected n_in %d / ws_size %zu\n", n_in, ws_size);
    }
    Params p{};
    for (int i = 0; i < 17; ++i) p.in[i] = (const float*)d_in[i];
    p.out = (float*)d_out; p.ws = (unsigned char*)d_ws;
    if (hipMemsetAsync((char*)d_ws + WS_CTL, 0, CTL_BYTES, stream) != hipSuccess) fprintf(stderr, "kernel_launch: memset of the barrier words failed\n");
    void* args[] = {&p};
    hipError_t e = hipLaunchCooperativeKernel((const void*)mega_fwd, dim3(grid), dim3(NTHREADS), args, LDS_BYTES, stream);
    if (e != hipSuccess) fprintf(stderr, "launch failed: %s (grid %d)\n", hipGetErrorString(e), grid);
}
```
